# Optimizing an MI355X kernel written in HIP

```python
import jax
import jax.numpy as jnp
from jax import lax
import numpy as np

D_MODEL = 1024
BATCH = 2
SEQ = 8192
DEPTH = 2

GRID_W = 64
CTX_LEN = 256
N_MIXERS = 2
N_FOURIER_LAYERS = (DEPTH + 1) // 2
N_HGRN_LAYERS = DEPTH // 2
FNET_GROUPS = 4
FNET_GROUP_DIM = D_MODEL // FNET_GROUPS
HGRN_HEADS = 8
HGRN_KEY_DIM = 128
HGRN_VALUE_DIM = D_MODEL // HGRN_HEADS
HGRN_F_DIM = HGRN_HEADS * HGRN_KEY_DIM
HGRN_CHUNK = 64
N_EXPERTS = 32
TOP_K = 4
D_FF = 1024
SWIGLU_ALPHA = 1.702
SWIGLU_LIMIT = 7.0
MOE_BLOCK = 256
NORM_EPS = 1e-6

kernel_name = 'hybrid_fnet_hgrn2_moe_dit'


def rms_norm(x, g):
    xf = x.astype(jnp.float32)
    y = xf * lax.rsqrt(jnp.mean(xf * xf, axis=-1, keepdims=True) + NORM_EPS)
    return (y * g.astype(jnp.float32)).astype(x.dtype)


def adaln(cond, w, b):
    m = jax.nn.silu(cond) @ w + b
    return jnp.split(m[..., None, :], 6, axis=-1)


def modulate(x, g, shift, scale):
    return rms_norm(x, g) * (1 + scale) + shift


def fourier_tokens(u, grid):
    bsz, length, _ = u.shape
    uf = u.astype(jnp.float32)
    if grid is None:
        ug = uf.reshape(bsz, length, FNET_GROUPS, FNET_GROUP_DIM)
        y = jnp.fft.fftn(ug, axes=(1, 3), norm='ortho').real
    else:
        rows, cols = grid
        ug = uf.reshape(bsz, rows, cols, FNET_GROUPS, FNET_GROUP_DIM)
        y = jnp.fft.fftn(ug, axes=(1, 2, 4), norm='ortho').real
    return y.reshape(bsz, length, D_MODEL).astype(u.dtype)


def fourier_mixer(h_ctx, h_lat, w_in, w_out, grid, need_ctx):
    y_lat = fourier_tokens(h_lat @ w_in, grid) @ w_out
    y_ctx = fourier_tokens(h_ctx @ w_in, None) @ w_out if need_ctx else None
    return y_ctx, y_lat


def gla_chunk_scan(q, k, v, log_f, s0):
    bsz, length, heads, _ = q.shape
    n_chunks = length // HGRN_CHUNK

    def chunks(t):
        return t.reshape(bsz, n_chunks, HGRN_CHUNK, heads, t.shape[-1]).transpose(1, 0, 3, 2, 4)

    lower_tri = jnp.tril(jnp.ones((HGRN_CHUNK, HGRN_CHUNK), dtype=bool))

    def step(s, blk):
        qc, kc, vc, ac = blk
        b = jnp.cumsum(ac, axis=2)
        b_last = b[:, :, -1:, :]
        diff = b[:, :, :, None, :] - b[:, :, None, :, :]
        decay = jnp.where(lower_tri[:, :, None], jnp.exp(jnp.minimum(diff, 0.0)), 0.0)
        scores = jnp.einsum('bhtk,bhsk,bhtsk->bhts', qc, kc, decay)
        o = (jnp.einsum('bhts,bhsv->bhtv', scores, vc)
             + jnp.einsum('bhtk,bhkv->bhtv', qc * jnp.exp(b), s))
        s_new = (jnp.exp(b_last[:, :, 0, :])[..., None] * s
                 + jnp.einsum('bhsk,bhsv->bhkv', kc * jnp.exp(b_last - b), vc))
        return s_new, o

    s_fin, o = lax.scan(step, s0, (chunks(q), chunks(k), chunks(v), chunks(log_f)))
    o = o.transpose(1, 0, 3, 2, 4).reshape(bsz, length, heads, v.shape[-1])
    return o, s_fin


def bidir_scan(q, k_fw, a_fw, k_bw, a_bw, v, s_fw, s_bw):
    o_fw, s_fw = gla_chunk_scan(q, k_fw, v, a_fw, s_fw)
    flip = lambda t: t[:, ::-1]
    o_bw, s_bw = gla_chunk_scan(flip(q), flip(k_bw), flip(v), flip(a_bw), s_bw)
    return o_fw + flip(o_bw), s_fw, s_bw


def hgrn2_mixer(h_ctx, h_lat, w_in, lb, norm_g, w_out, need_ctx):
    splits = [HGRN_F_DIM, 2 * HGRN_F_DIM, 3 * HGRN_F_DIM, 3 * HGRN_F_DIM + D_MODEL]

    def project(h):
        bsz, length, _ = h.shape
        q, f_fw, f_bw, i_in, g = jnp.split(h @ w_in, splits, axis=-1)
        heads = lambda t: t.reshape(bsz, length, HGRN_HEADS, -1)
        fg_fw = lb[0] + (1 - lb[0]) * jax.nn.sigmoid(f_fw.astype(jnp.float32))
        fg_bw = lb[1] + (1 - lb[1]) * jax.nn.sigmoid(f_bw.astype(jnp.float32))
        scan_in = (heads(jax.nn.silu(q).astype(jnp.float32)),
                   heads(1 - fg_fw), heads(jnp.log(fg_fw)),
                   heads(1 - fg_bw), heads(jnp.log(fg_bw)),
                   heads(i_in.astype(jnp.float32)))
        return scan_in, g

    def readout(o, g):
        bsz, length = o.shape[:2]
        on = (o * lax.rsqrt(jnp.mean(o * o, axis=-1, keepdims=True) + NORM_EPS)
              * norm_g.astype(jnp.float32).reshape(HGRN_HEADS, HGRN_VALUE_DIM))
        y = on.reshape(bsz, length, D_MODEL).astype(g.dtype) * jax.nn.silu(g)
        return y @ w_out

    ctx_in, g_ctx = project(h_ctx)
    lat_in, g_lat = project(h_lat)
    s0 = jnp.zeros((h_lat.shape[0], HGRN_HEADS, HGRN_KEY_DIM, HGRN_VALUE_DIM), jnp.float32)
    o_ctx, s_fw, s_bw = bidir_scan(*ctx_in, s0, s0)
    o_lat, _, _ = bidir_scan(*lat_in, s_fw, s_bw)
    y_lat = readout(o_lat, g_lat)
    y_ctx = readout(o_ctx, g_ctx) if need_ctx else None
    return y_ctx, y_lat


def moe_ffn(h, w_r, b_r, w1, b1, w2, b2):
    n_tok = h.shape[0]
    logits = (h @ w_r + b_r).astype(jnp.float32)
    top_val, top_idx = lax.top_k(logits, TOP_K)
    gate = jax.nn.softmax(top_val, axis=-1)
    n_assign = n_tok * TOP_K
    flat_e = top_idx.reshape(-1)
    order = jnp.argsort(flat_e)
    e_sorted = flat_e[order]
    tok_sorted = order // TOP_K
    gate_sorted = gate.reshape(-1)[order]
    counts = jnp.bincount(flat_e, length=N_EXPERTS)
    padded = (counts + MOE_BLOCK - 1) // MOE_BLOCK * MOE_BLOCK
    pad_end = jnp.cumsum(padded)
    pad_start = pad_end - padded
    start = jnp.cumsum(counts) - counts
    dest = pad_start[e_sorted] + jnp.arange(n_assign) - start[e_sorted]
    n_blocks = -(-n_assign // MOE_BLOCK) + N_EXPERTS
    n_rows = n_blocks * MOE_BLOCK
    row_tok = jnp.zeros((n_rows,), jnp.int32).at[dest].set(tok_sorted.astype(jnp.int32))
    row_gate = jnp.zeros((n_rows,), jnp.float32).at[dest].set(gate_sorted)
    block_exp = jnp.minimum(
        jnp.searchsorted(pad_end, jnp.arange(n_blocks) * MOE_BLOCK, side='right'), N_EXPERTS - 1)
    xb = h[row_tok].reshape(n_blocks, MOE_BLOCK, h.shape[-1])

    def expert_block(args):
        xblk, e = args
        u = xblk @ w1[e] + b1[e]
        glu, lin = jnp.split(u, 2, axis=-1)
        glu = jnp.minimum(glu, SWIGLU_LIMIT)
        lin = jnp.clip(lin, -SWIGLU_LIMIT, SWIGLU_LIMIT)
        act = glu * jax.nn.sigmoid(SWIGLU_ALPHA * glu) * (lin + 1)
        return act @ w2[e] + b2[e]

    yb = lax.map(expert_block, (xb, block_exp)).reshape(n_rows, -1)
    y = yb * row_gate[:, None].astype(yb.dtype)
    return jax.ops.segment_sum(y, row_tok, num_segments=n_tok)


def setup_inputs(seed: int = 0) -> dict:
    key = jax.random.key(seed)
    ks = jax.random.split(key, 21)
    nrm = lambda k, shape, scale: jax.random.normal(k, shape, jnp.float32) * scale
    D = D_MODEL
    return {
        'x': nrm(ks[0], (BATCH, SEQ, D), 1.0),
        'c': nrm(ks[1], (BATCH, D), 1.0),
        'ctx': nrm(ks[2], (BATCH, CTX_LEN, D), 1.0),
        'c_ctx': nrm(ks[3], (D,), 1.0),
        'mod_w': nrm(ks[4], (DEPTH, D, 6 * D), 0.5 * D ** -0.5),
        'mod_b': nrm(ks[5], (DEPTH, 6 * D), 0.02),
        'norm1_g': 1.0 + nrm(ks[6], (DEPTH, D), 0.02),
        'norm2_g': 1.0 + nrm(ks[7], (DEPTH, D), 0.02),
        'fourier_w_in': nrm(ks[8], (N_FOURIER_LAYERS, D, D), D ** -0.5),
        'fourier_w_out': nrm(ks[9], (N_FOURIER_LAYERS, D, D), D ** -0.5),
        'hgrn_w_in': nrm(ks[10], (N_HGRN_LAYERS, D, 3 * HGRN_F_DIM + 2 * D), D ** -0.5),
        'hgrn_lower_bounds': nrm(ks[11], (DEPTH, 2, HGRN_F_DIM), 0.5),
        'hgrn_norm_g': 1.0 + nrm(ks[12], (N_HGRN_LAYERS, D), 0.02),
        'hgrn_w_out': nrm(ks[13], (N_HGRN_LAYERS, D, D), D ** -0.5),
        'router_w': nrm(ks[14], (DEPTH, D, N_EXPERTS), D ** -0.5),
        'router_b': nrm(ks[15], (DEPTH, N_EXPERTS), 0.01),
        'expert_w1': nrm(ks[16], (DEPTH, N_EXPERTS, D, 2 * D_FF), D ** -0.5),
        'expert_b1': nrm(ks[17], (DEPTH, N_EXPERTS, 2 * D_FF), 0.01),
        'expert_w2': nrm(ks[18], (DEPTH, N_EXPERTS, D_FF, D), D_FF ** -0.5),
        'expert_b2': nrm(ks[19], (DEPTH, N_EXPERTS, D), 0.01),
        'final_norm_g': 1.0 + nrm(ks[20], (D,), 0.02),
    }


def reference(x, c, ctx, c_ctx, mod_w, mod_b, norm1_g, norm2_g, fourier_w_in, fourier_w_out,
              hgrn_w_in, hgrn_lower_bounds, hgrn_norm_g, hgrn_w_out, router_w, router_b,
              expert_w1, expert_b1, expert_w2, expert_b2, final_norm_g):
    lb_soft = jax.nn.softmax(hgrn_lower_bounds.astype(jnp.float32), axis=0)
    lower_bounds = jnp.cumsum(lb_soft, axis=0) - lb_soft[0]
    rows = x.shape[1] // GRID_W
    grid = (rows, GRID_W)
    x_lat, x_ctx = x, ctx
    for i in range(DEPTH):
        need_ctx = i < DEPTH - 1
        sh1, sc1, g1, sh2, sc2, g2 = adaln(c, mod_w[i], mod_b[i])
        csh1, csc1, cg1, csh2, csc2, cg2 = adaln(c_ctx, mod_w[i], mod_b[i])
        h_lat = modulate(x_lat, norm1_g[i], sh1, sc1)
        h_ctx = modulate(x_ctx, norm1_g[i], csh1, csc1)
        j = i // N_MIXERS
        if i % N_MIXERS == 0:
            y_ctx, y_lat = fourier_mixer(h_ctx, h_lat, fourier_w_in[j], fourier_w_out[j],
                                         grid, need_ctx)
        else:
            y_ctx, y_lat = hgrn2_mixer(h_ctx, h_lat, hgrn_w_in[j], lower_bounds[i],
                                       hgrn_norm_g[j], hgrn_w_out[j], need_ctx)
        x_lat = x_lat + g1 * y_lat
        h_lat = modulate(x_lat, norm2_g[i], sh2, sc2)
        moe_args = (router_w[i], router_b[i], expert_w1[i], expert_b1[i],
                    expert_w2[i], expert_b2[i])
        if need_ctx:
            x_ctx = x_ctx + cg1 * y_ctx
            h_ctx = modulate(x_ctx, norm2_g[i], csh2, csc2)
            n_ctx = x_ctx.shape[0] * x_ctx.shape[1]
            tokens = jnp.concatenate([h_ctx.reshape(-1, D_MODEL), h_lat.reshape(-1, D_MODEL)], axis=0)
            out = moe_ffn(tokens, *moe_args)
            x_ctx = x_ctx + cg2 * out[:n_ctx].reshape(x_ctx.shape)
            x_lat = x_lat + g2 * out[n_ctx:].reshape(x_lat.shape)
        else:
            out = moe_ffn(h_lat.reshape(-1, D_MODEL), *moe_args)
            x_lat = x_lat + g2 * out.reshape(x_lat.shape)
    return rms_norm(x_lat, final_norm_g)
```

```cpp
#include <hip/hip_runtime.h>
#include <cstdio>
#include <cstdint>

#define LAS __attribute__((address_space(3)))
typedef unsigned short bf16_t;
typedef short bf16x8 __attribute__((ext_vector_type(8)));
typedef float f32x4 __attribute__((ext_vector_type(4)));
typedef float f32x2 __attribute__((ext_vector_type(2)));
typedef unsigned u32x4 __attribute__((ext_vector_type(4)));
typedef unsigned u32x2 __attribute__((ext_vector_type(2)));

constexpr int D = 1024, NBATCH = 2, SEQ = 8192, CTXL = 256;
constexpr int NCTX = NBATCH * CTXL;
constexpr int NLAT = NBATCH * SEQ;
constexpr int NTOK = NCTX + NLAT;
constexpr int NE = 32, DFF = 1024, NH = 8, HD = 128;
constexpr int NHI = 5 * D;
constexpr int MAXROWS = (((NTOK * 4) + 255) / 256 + NE) * 256;
constexpr float EPS = 1e-6f;
constexpr int NPH = 18;

constexpr size_t MiB = 1u << 20;
constexpr size_t WS_CTL = 0, CTL_BYTES = 1 * MiB;
constexpr size_t CTL_CNT = 64 * 1024;
constexpr size_t CTL_MOD = 128 * 1024;
constexpr size_t WS_LB = 1 * MiB;
constexpr size_t WS_TAB = 2 * MiB;
constexpr size_t TAB_T64 = 0, TAB_T128A = 16384, TAB_T128B = TAB_T128A + 65536, TAB_T256 = TAB_T128B + 65536,
                 TAB_C256 = TAB_T256 + 262144, TAB_S256 = TAB_C256 + 131072;
constexpr size_t WS_WINB = 4 * MiB, WS_WOUTT = 6 * MiB, WS_TAB2 = 8 * MiB, WS_WABT = 12 * MiB, WS_WHIT = 16 * MiB, WS_WHOT = 26 * MiB;
constexpr size_t WS_ROUTE = 28 * MiB;
constexpr size_t RT_LIST = 0, RT_ASGE = 2304 * 1024, RT_ASGP = RT_ASGE + 320 * 1024, RT_GATE = RT_ASGP + 320 * 1024;
constexpr size_t WS_W1T = 32 * MiB, WS_W2T = 288 * MiB;
constexpr size_t WS_HB = 416 * MiB, WS_X1 = 450 * MiB, WS_X2 = 516 * MiB, WS_Z1 = 582 * MiB, WS_Z = 648 * MiB;
constexpr size_t WS_ACT = 714 * MiB, WS_YB = 862 * MiB;
constexpr size_t WS_QB = 1010 * MiB, WS_KFW = 1044 * MiB, WS_KBW = 1078 * MiB, WS_VB = 1112 * MiB, WS_SGB = 1146 * MiB;
constexpr size_t WS_AFW = 1180 * MiB, WS_ABW = 1246 * MiB, WS_OFW = 1312 * MiB, WS_OBW = 1344 * MiB, WS_YR = 1376 * MiB;
constexpr size_t WS_SLOC = 1408 * MiB, WS_DSUM = 1424 * MiB, WS_END = 1426 * MiB;

constexpr int LDS_BYTES = 160 * 1024;
constexpr int LDS_MISC = LDS_BYTES - 1024;

struct P {
    const float *x, *c, *ctx, *c_ctx, *mod_w, *mod_b, *norm1_g, *norm2_g, *f_w_in, *f_w_out, *h_w_in, *h_lb, *h_norm_g, *h_w_out,
                *router_w, *router_b, *e_w1, *e_b1, *e_w2, *e_b2, *final_g;
    float* out; unsigned char* ws;
};
struct Args { const void* in[21]; float* out; unsigned char* ws; int ph_lo, ph_hi; };

__device__ __forceinline__ unsigned f2bf(float f) { unsigned u = __float_as_uint(f); return (u + 0x7fffu + ((u >> 16) & 1u)) >> 16; }
__device__ __forceinline__ unsigned pk2(float lo, float hi) { return f2bf(lo) | (f2bf(hi) << 16); }
__device__ __forceinline__ float bf2f(unsigned b) { return __uint_as_float(b << 16); }
__device__ __forceinline__ float sigmoidf_(float v) { return 1.f / (1.f + __expf(-v)); }
__device__ __forceinline__ float siluf_(float v) { return v / (1.f + __expf(-v)); }
__device__ __forceinline__ float wave_sum(float v) {
#pragma unroll
    for (int o = 1; o < 64; o <<= 1) v += __shfl_xor(v, o);
    return v;
}
#define LDS_WAIT() asm volatile("s_waitcnt lgkmcnt(0)" ::: "memory")

__device__ __forceinline__ const float* modp(const P& p, int l, int c, int q) { return (const float*)(p.ws + CTL_MOD) + ((size_t)(l * 3 + c) * 6 + q) * D; }
__device__ __forceinline__ int row_cond(int row) { return row < NCTX ? 2 : ((row - NCTX) >> 13); }

__device__ __forceinline__ void transpose_item(const float* W, int K, int N, bf16_t* WT, LAS float* scr, int item, int lane) {
    const int nblk = N / 32, kb = item / nblk, nb = item % nblk, k0 = 64 * kb, n0 = 32 * nb;
#pragma unroll 8
    for (int i = 0; i < 32; ++i) { const int kk = 2 * i + (lane >> 5); scr[kk * 33 + (lane & 31)] = W[(size_t)(k0 + kk) * N + n0 + (lane & 31)]; }
    LDS_WAIT();
    const int c = lane & 7;
#pragma unroll
    for (int j = 0; j < 4; ++j) { const int n = (lane >> 3) + 8 * j; const LAS float* s = scr + (8 * c) * 33 + n;
        u32x4 o; o.x = pk2(s[0 * 33], s[1 * 33]); o.y = pk2(s[2 * 33], s[3 * 33]); o.z = pk2(s[4 * 33], s[5 * 33]); o.w = pk2(s[6 * 33], s[7 * 33]);
        *(u32x4*)(WT + (size_t)(n0 + n) * K + k0 + 8 * c) = o; }
    LDS_WAIT();
}

__device__ __forceinline__ void ph_prologue(const P& p, LAS unsigned char* lds) {
    const int tid = threadIdx.x, lane = tid & 63, wave = tid >> 6, G = gridDim.x, bid = blockIdx.x;
    {
        LAS float* sc = (LAS float*)lds;
        LAS float* red = sc + 3 * D;
        __syncthreads();
        for (int e = tid; e < 3 * D; e += 512) { const int c = e >> 10, k = e & 1023; const float v = (c < 2) ? p.c[c * D + k] : p.c_ctx[k]; sc[e] = siluf_(v); }
        __syncthreads();
        const int cq = tid & 15, kg = tid >> 4;
        for (int it = bid; it < 192; it += G) {
            const int l = it / 96, cb = it % 96;
            const float* w = p.mod_w + ((size_t)l * D + kg * 32) * 6144 + cb * 64 + 4 * cq;
            f32x4 a0 = {0.f, 0.f, 0.f, 0.f}, a1 = a0, a2 = a0;
#pragma unroll 8
            for (int kk = 0; kk < 32; ++kk) { const f32x4 wv = *(const f32x4*)(w + (size_t)kk * 6144); const int k = kg * 32 + kk;
                a0 += wv * sc[k]; a1 += wv * sc[D + k]; a2 += wv * sc[2 * D + k]; }
            *(LAS f32x4*)(red + (kg * 3 + 0) * 64 + 4 * cq) = a0; *(LAS f32x4*)(red + (kg * 3 + 1) * 64 + 4 * cq) = a1; *(LAS f32x4*)(red + (kg * 3 + 2) * 64 + 4 * cq) = a2;
            __syncthreads();
            if (tid < 192) { const int c = tid >> 6, col = tid & 63; float s = p.mod_b[l * 6144 + cb * 64 + col];
                for (int g2 = 0; g2 < 32; ++g2) s += red[(g2 * 3 + c) * 64 + col];
                ((float*)(p.ws + CTL_MOD))[(size_t)(l * 3 + c) * 6144 + cb * 64 + col] = s; }
            __syncthreads();
        }
    }
    const int gt = bid * 512 + tid, NT = G * 512;
    for (int i = gt; i < 2048; i += NT) ((float*)(p.ws + WS_LB))[i] = sigmoidf_(p.h_lb[2048 + i] - p.h_lb[i]);
    {
        bf16_t* tb = (bf16_t*)(p.ws + WS_TAB);
        for (int e = gt; e < 335872; e += NT) {
            int r = e; float v; bf16_t* dst;
            if (r < 8192) { const int m = r >> 6, k = r & 63; const int mm = m & 63; const float a = 2.f * (float)((mm * k) & 63) / 64.f;
                v = (m < 64 ? cospif(a) : -sinpif(a)) * 0.125f; dst = tb + TAB_T64 / 2 + r; }
            else if ((r -= 8192) < 32768) { const int m = r >> 7, k = r & 127; const int mm = m & 127; const float a = 2.f * (float)((mm * k) & 127) / 128.f;
                v = (m < 128 ? cospif(a) : -sinpif(a)) * 0.08838834764831845f; dst = tb + TAB_T128A / 2 + r; }
            else if ((r -= 32768) < 32768) { const int m = r >> 7, k = r & 127; const int mm = m & 127; const float a = 2.f * (float)((mm * k) & 127) / 128.f;
                v = (m < 128 ? sinpif(a) : cospif(a)) * 0.08838834764831845f; dst = tb + TAB_T128B / 2 + r; }
            else if ((r -= 32768) < 131072) { const int m = r >> 8, k = r & 255; const int mm = m & 255; const float a = 2.f * (float)((mm * k) & 255) / 256.f;
                v = (m < 256 ? cospif(a) : -sinpif(a)) * 0.0625f; dst = tb + TAB_T256 / 2 + r; }
            else if ((r -= 131072) < 65536) { const int m = r >> 8, k = r & 255; const float a = 2.f * (float)((m * k) & 255) / 256.f; v = cospif(a) * 0.0625f; dst = tb + TAB_C256 / 2 + r; }
            else { r -= 65536; const int m = r >> 8, k = r & 255; const float a = 2.f * (float)((m * k) & 255) / 256.f; v = sinpif(a) * 0.0625f; dst = tb + TAB_S256 / 2 + r; }
            *dst = (bf16_t)f2bf(v);
        }
    }
    { bf16_t* wb = (bf16_t*)(p.ws + WS_WINB);
      for (int e = gt; e < D * D / 4; e += NT) { const f32x4 v = ((const f32x4*)p.f_w_in)[e]; u32x2 o; o.x = pk2(v.x, v.y); o.y = pk2(v.z, v.w); ((u32x2*)wb)[e] = o; } }
    {
        LAS float* scr = (LAS float*)(lds + wave * 8704);
        const int gw = bid * 8 + wave, NGW = G * 8;
        constexpr int I_FO = 16 * 32, I_HI = 16 * 160, I_HO = 16 * 32, I_W1 = 16 * 64, I_W2 = 16 * 32;
        constexpr int NIT = I_FO + I_HI + I_HO + 64 * I_W1 + 64 * I_W2;
        for (int it = gw; it < NIT; it += NGW) {
            int r = it;
            if (r < I_FO) { transpose_item(p.f_w_out, D, D, (bf16_t*)(p.ws + WS_WOUTT), scr, r, lane); continue; } r -= I_FO;
            if (r < I_HI) { transpose_item(p.h_w_in, D, NHI, (bf16_t*)(p.ws + WS_WHIT), scr, r, lane); continue; } r -= I_HI;
            if (r < I_HO) { transpose_item(p.h_w_out, D, D, (bf16_t*)(p.ws + WS_WHOT), scr, r, lane); continue; } r -= I_HO;
            if (r < 64 * I_W1) { const int mtx = r / I_W1; transpose_item(p.e_w1 + (size_t)mtx * D * 2 * DFF, D, 2 * DFF, (bf16_t*)(p.ws + WS_W1T) + (size_t)mtx * D * 2 * DFF, scr, r % I_W1, lane); continue; } r -= 64 * I_W1;
            { const int mtx = r / I_W2; transpose_item(p.e_w2 + (size_t)mtx * DFF * D, DFF, D, (bf16_t*)(p.ws + WS_W2T) + (size_t)mtx * DFF * D, scr, r % I_W2, lane); }
        }
    }
}

template <class AF, class BF, class EF>
__device__ __forceinline__ void sgemm_unit(const AF& af, const BF& bf, const EF& ef, int K) {
    const int tid = threadIdx.x, lane = tid & 63, wid = tid >> 6, wr = wid >> 2, wc = wid & 3, fr = lane & 15, fq = lane >> 4;
    const bf16_t* ap[4]; const bf16_t* bp[4];
#pragma unroll
    for (int i = 0; i < 4; ++i) { ap[i] = af.row(wr * 64 + i * 16 + fr) + fq * 8; bp[i] = bf.row(wc * 64 + i * 16 + fr) + fq * 8; }
    f32x4 acc[4][4];
#pragma unroll
    for (int i = 0; i < 4; ++i)
#pragma unroll
        for (int j = 0; j < 4; ++j) acc[i][j] = (f32x4){0.f, 0.f, 0.f, 0.f};
    bf16x8 a[4], b[4], a2[4], b2[4];
#pragma unroll
    for (int i = 0; i < 4; ++i) { a[i] = *(const bf16x8*)(ap[i]); b[i] = *(const bf16x8*)(bp[i]); }
    for (int k0 = 0; k0 < K; k0 += 64) {
#pragma unroll
        for (int i = 0; i < 4; ++i) { a2[i] = *(const bf16x8*)(ap[i] + k0 + 32); b2[i] = *(const bf16x8*)(bp[i] + k0 + 32); }
#pragma unroll
        for (int i = 0; i < 4; ++i)
#pragma unroll
            for (int j = 0; j < 4; ++j) acc[i][j] = __builtin_amdgcn_mfma_f32_16x16x32_bf16(b[j], a[i], acc[i][j], 0, 0, 0);
        if (k0 + 64 < K) {
#pragma unroll
            for (int i = 0; i < 4; ++i) { a[i] = *(const bf16x8*)(ap[i] + k0 + 64); b[i] = *(const bf16x8*)(bp[i] + k0 + 64); }
        }
#pragma unroll
        for (int i = 0; i < 4; ++i)
#pragma unroll
            for (int j = 0; j < 4; ++j) acc[i][j] = __builtin_amdgcn_mfma_f32_16x16x32_bf16(b2[j], a2[i], acc[i][j], 0, 0, 0);
    }
    ef(acc, wr, wc, fr, fq);
}
struct RowsDense { const bf16_t* base; size_t ld; __device__ __forceinline__ const bf16_t* row(int i) const { return base + (size_t)i * ld; } };

__device__ __forceinline__ void st_bf4(bf16_t* p, f32x4 v) { u32x2 o; o.x = pk2(v.x, v.y); o.y = pk2(v.z, v.w); *(u32x2*)p = o; }

struct EpiBf16Plain { bf16_t* C; size_t ld;
    __device__ __forceinline__ void operator()(const f32x4 (&acc)[4][4], int wr, int wc, int fr, int fq) const {
#pragma unroll
        for (int mi = 0; mi < 4; ++mi)
#pragma unroll
            for (int ni = 0; ni < 4; ++ni) st_bf4(C + (size_t)(wr * 64 + mi * 16 + fr) * ld + wc * 64 + ni * 16 + 4 * fq, acc[mi][ni]);
    } };
template <bool FOURIER> struct EpiResidual { const P* p; int m0, n0, layer;
    __device__ __forceinline__ void operator()(const f32x4 (&acc)[4][4], int wr, int wc, int fr, int fq) const {
        float* X1 = (float*)(p->ws + WS_X1);
#pragma unroll
        for (int mi = 0; mi < 4; ++mi) {
            const int m = m0 + wr * 64 + mi * 16 + fr; int row = m;
            if (FOURIER && m >= NCTX) { const int mm = m - NCTX, b = mm >> 13, rem = mm & 8191, cc = rem >> 7, rr = rem & 127; row = NCTX + b * SEQ + rr * 64 + cc; }
            const int cond = row_cond(row);
            const float* xin;
            if (FOURIER) xin = (row < NCTX) ? p->ctx + (size_t)row * D : p->x + (size_t)(row - NCTX) * D;
            else xin = (const float*)(p->ws + WS_X2) + (size_t)row * D;
            const float* g = modp(*p, layer, cond, 2);
#pragma unroll
            for (int ni = 0; ni < 4; ++ni) { const int n = n0 + wc * 64 + ni * 16 + 4 * fq;
                const f32x4 xv = *(const f32x4*)(xin + n), gv = *(const f32x4*)(g + n);
                *(f32x4*)(X1 + (size_t)row * D + n) = xv + gv * acc[mi][ni]; }
        }
    } };
struct EpiSwiglu { bf16_t* act; const float* b1; int colbase;
    __device__ __forceinline__ void operator()(const f32x4 (&acc)[4][4], int wr, int wc, int fr, int fq) const {
#pragma unroll
        for (int mi = 0; mi < 4; ++mi)
#pragma unroll
            for (int ni = 0; ni < 2; ++ni) { const int col = colbase + wc * 32 + ni * 16 + 4 * fq;
                const f32x4 bg = *(const f32x4*)(b1 + col), bl = *(const f32x4*)(b1 + DFF + col); f32x4 o;
#pragma unroll
                for (int j = 0; j < 4; ++j) { float gl = acc[mi][ni][j] + bg[j], li = acc[mi][ni + 2][j] + bl[j];
                    gl = fminf(gl, 7.f); li = fminf(fmaxf(li, -7.f), 7.f); o[j] = gl * sigmoidf_(1.702f * gl) * (li + 1.f); }
                st_bf4(act + (size_t)(wr * 64 + mi * 16 + fr) * DFF + col, o); }
    } };
struct EpiBias { bf16_t* C; const float* bias; int n0;
    __device__ __forceinline__ void operator()(const f32x4 (&acc)[4][4], int wr, int wc, int fr, int fq) const {
#pragma unroll
        for (int mi = 0; mi < 4; ++mi)
#pragma unroll
            for (int ni = 0; ni < 4; ++ni) { const int n = n0 + wc * 64 + ni * 16 + 4 * fq; const f32x4 bv = *(const f32x4*)(bias + n);
                st_bf4(C + (size_t)(wr * 64 + mi * 16 + fr) * D + n, acc[mi][ni] + bv); }
    } };
struct EpiHgrnIn { const P* p; int m0, n0;
    __device__ __forceinline__ void operator()(const f32x4 (&acc)[4][4], int wr, int wc, int fr, int fq) const {
        const int seg = n0 >> 10; const float* lb = (const float*)(p->ws + WS_LB);
#pragma unroll
        for (int mi = 0; mi < 4; ++mi) { const size_t row = (size_t)(m0 + wr * 64 + mi * 16 + fr);
#pragma unroll
            for (int ni = 0; ni < 4; ++ni) { const int col = (n0 & 1023) + wc * 64 + ni * 16 + 4 * fq; const f32x4 v = acc[mi][ni];
                if (seg == 0) { f32x4 o; for (int j = 0; j < 4; ++j) o[j] = siluf_(v[j]); st_bf4((bf16_t*)(p->ws + WS_QB) + row * D + col, o); }
                else if (seg == 1 || seg == 2) { const f32x4 l4 = *(const f32x4*)(lb + (seg - 1) * D + col); f32x4 kk, aa;
                    for (int j = 0; j < 4; ++j) { const float s = sigmoidf_(v[j]); const float fg = l4[j] + (1.f - l4[j]) * s; kk[j] = (1.f - l4[j]) * (1.f - s); aa[j] = logf(fg); }
                    st_bf4((bf16_t*)(p->ws + (seg == 1 ? WS_KFW : WS_KBW)) + row * D + col, kk);
                    *(f32x4*)((float*)(p->ws + (seg == 1 ? WS_AFW : WS_ABW)) + row * D + col) = aa; }
                else if (seg == 3) st_bf4((bf16_t*)(p->ws + WS_VB) + row * D + col, v);
                else { f32x4 o; for (int j = 0; j < 4; ++j) o[j] = siluf_(v[j]); st_bf4((bf16_t*)(p->ws + WS_SGB) + row * D + col, o); }
            } }
    } };

template <int KD, bool TWO>
__device__ __forceinline__ void dft_unit(LAS unsigned char* lds, const bf16_t* x1, const bf16_t* x2, size_t xpitch, const bf16_t* T1, const bf16_t* T2, bf16_t* obase, size_t opitch) {
    constexpr int PITCH = KD + 8;
    LAS bf16_t* XT1 = (LAS bf16_t*)lds; LAS bf16_t* XT2 = XT1 + 64 * PITCH;
    const int tid = threadIdx.x, lane = tid & 63, wid = tid >> 6, fr = lane & 15, fq = lane >> 4;
    __syncthreads();
    for (int e = tid; e < KD * 8; e += 512) { const int k = e >> 3, c8 = (e & 7) * 8;
        const u32x4 v = *(const u32x4*)(x1 + (size_t)k * xpitch + c8);
        const unsigned w[4] = {v.x, v.y, v.z, v.w};
#pragma unroll
        for (int j = 0; j < 4; ++j) { XT1[(c8 + 2 * j) * PITCH + k] = (bf16_t)(w[j] & 0xffffu); XT1[(c8 + 2 * j + 1) * PITCH + k] = (bf16_t)(w[j] >> 16); }
        if (TWO) { const u32x4 v2 = *(const u32x4*)(x2 + (size_t)k * xpitch + c8); const unsigned w2[4] = {v2.x, v2.y, v2.z, v2.w};
#pragma unroll
            for (int j = 0; j < 4; ++j) { XT2[(c8 + 2 * j) * PITCH + k] = (bf16_t)(w2[j] & 0xffffu); XT2[(c8 + 2 * j + 1) * PITCH + k] = (bf16_t)(w2[j] >> 16); } }
    }
    __syncthreads();
    constexpr int MT = (2 * KD) / 8 / 16;
    f32x4 acc[MT][4];
#pragma unroll
    for (int i = 0; i < MT; ++i)
#pragma unroll
        for (int j = 0; j < 4; ++j) acc[i][j] = (f32x4){0.f, 0.f, 0.f, 0.f};
    const int mrow0 = wid * (MT * 16);
    for (int k0 = 0; k0 < KD; k0 += 32) {
        bf16x8 xb[4], ta[MT];
#pragma unroll
        for (int ni = 0; ni < 4; ++ni) xb[ni] = *(const LAS bf16x8*)(XT1 + (ni * 16 + fr) * PITCH + k0 + fq * 8);
#pragma unroll
        for (int mi = 0; mi < MT; ++mi) ta[mi] = *(const bf16x8*)(T1 + (size_t)(mrow0 + mi * 16 + fr) * KD + k0 + fq * 8);
#pragma unroll
        for (int mi = 0; mi < MT; ++mi)
#pragma unroll
            for (int ni = 0; ni < 4; ++ni) acc[mi][ni] = __builtin_amdgcn_mfma_f32_16x16x32_bf16(xb[ni], ta[mi], acc[mi][ni], 0, 0, 0);
        if (TWO) {
#pragma unroll
            for (int ni = 0; ni < 4; ++ni) xb[ni] = *(const LAS bf16x8*)(XT2 + (ni * 16 + fr) * PITCH + k0 + fq * 8);
#pragma unroll
            for (int mi = 0; mi < MT; ++mi) ta[mi] = *(const bf16x8*)(T2 + (size_t)(mrow0 + mi * 16 + fr) * KD + k0 + fq * 8);
#pragma unroll
            for (int mi = 0; mi < MT; ++mi)
#pragma unroll
                for (int ni = 0; ni < 4; ++ni) acc[mi][ni] = __builtin_amdgcn_mfma_f32_16x16x32_bf16(xb[ni], ta[mi], acc[mi][ni], 0, 0, 0);
        }
    }
#pragma unroll
    for (int mi = 0; mi < MT; ++mi) { const int m = mrow0 + mi * 16 + fr; bf16_t* orow = obase + (size_t)(m % KD) * opitch + (m >= KD ? D : 0);
#pragma unroll
        for (int ni = 0; ni < 4; ++ni) st_bf4(orow + ni * 16 + 4 * fq, acc[mi][ni]); }
}

struct RowVec { f32x4 v[4]; };
__device__ __forceinline__ RowVec ld_row_f32(const float* r, int lane) { RowVec o;
#pragma unroll
    for (int j = 0; j < 4; ++j) o.v[j] = *(const f32x4*)(r + 256 * j + 4 * lane);
    return o; }
__device__ __forceinline__ void st_row_f32(float* r, int lane, const RowVec& o) {
#pragma unroll
    for (int j = 0; j < 4; ++j) *(f32x4*)(r + 256 * j + 4 * lane) = o.v[j]; }
__device__ __forceinline__ void st_row_bf16(bf16_t* r, int lane, const RowVec& o) {
#pragma unroll
    for (int j = 0; j < 4; ++j) st_bf4(r + 256 * j + 4 * lane, o.v[j]); }
__device__ __forceinline__ float row_rs(const RowVec& x) { float s = 0.f;
#pragma unroll
    for (int j = 0; j < 4; ++j) s += (x.v[j].x * x.v[j].x + x.v[j].y * x.v[j].y) + (x.v[j].z * x.v[j].z + x.v[j].w * x.v[j].w);
    return rsqrtf(wave_sum(s) * (1.f / D) + EPS); }
__device__ __forceinline__ void ld_modvec(const P& p, const float* g, int l, int cond, int sub, int lane, RowVec& a, RowVec& s) {
    const RowVec gv = ld_row_f32(g, lane), sc = ld_row_f32(modp(p, l, cond, sub * 3 + 1), lane); s = ld_row_f32(modp(p, l, cond, sub * 3), lane);
#pragma unroll
    for (int j = 0; j < 4; ++j) a.v[j] = gv.v[j] * (sc.v[j] + 1.f); }
__device__ __forceinline__ void seg_range(int s, int& r0, int& n, int& cond) { if (s == 0) { r0 = 0; n = NCTX; cond = 2; } else { r0 = NCTX + (s - 1) * SEQ; n = SEQ; cond = s - 1; } }

__device__ __forceinline__ void ph_mod1_l0(const P& p) {
    const int lane = threadIdx.x & 63, gw = blockIdx.x * 8 + (threadIdx.x >> 6), NGW = gridDim.x * 8;
    bf16_t* Hb = (bf16_t*)(p.ws + WS_HB);
    for (int s = 0; s < 3; ++s) { int r0, n, cond; seg_range(s, r0, n, cond); RowVec a, sh; ld_modvec(p, p.norm1_g, 0, cond, 0, lane, a, sh);
        for (int r = gw; r < n; r += NGW) { const int row = r0 + r; const float* src = (s == 0) ? p.ctx + (size_t)row * D : p.x + (size_t)(row - NCTX) * D;
            RowVec x = ld_row_f32(src, lane); const float rs = row_rs(x);
#pragma unroll
            for (int j = 0; j < 4; ++j) x.v[j] = x.v[j] * rs * a.v[j] + sh.v[j];
            st_row_bf16(Hb + (size_t)row * D, lane, x); } }
}

constexpr int WR_PITCH = 36;
__device__ __forceinline__ void ph_mod2_route(const P& p, int l, LAS unsigned char* lds) {
    const int tid = threadIdx.x, lane = tid & 63, gw = blockIdx.x * 8 + (tid >> 6), NGW = gridDim.x * 8;
    LAS float* wr = (LAS float*)lds;
    __syncthreads();
    { const f32x4* src = (const f32x4*)(p.router_w + (size_t)l * D * NE);
      for (int e = tid; e < D * NE / 4; e += 512) { const int ch = e >> 3, q = e & 7; const int slot = (ch & 3) * 256 + (ch >> 8) * 64 + ((ch >> 2) & 63);
          *(LAS f32x4*)(wr + slot * WR_PITCH + q * 4) = src[e]; } }
    __syncthreads();
    bf16_t* Hb = (bf16_t*)(p.ws + WS_HB); const float* X1 = (const float*)(p.ws + WS_X1);
    int* cnt = (int*)(p.ws + CTL_CNT) + l * NE; int* list = (int*)(p.ws + WS_ROUTE + RT_LIST);
    int* asg_e = (int*)(p.ws + WS_ROUTE + RT_ASGE); int* asg_p = (int*)(p.ws + WS_ROUTE + RT_ASGP); float* gate = (float*)(p.ws + WS_ROUTE + RT_GATE);
    const int tokbase = (l == 0) ? 0 : NCTX;
    const int my_e = ((lane >> 5) & 1) * 16 + ((lane >> 4) & 1) * 8 + ((lane >> 3) & 1) * 4 + ((lane >> 2) & 1) * 2 + ((lane >> 1) & 1);
    const float my_b = p.router_b[l * NE + my_e];
    for (int s = (l == 0 ? 0 : 1); s < 3; ++s) { int r0, n, cond; seg_range(s, r0, n, cond); RowVec a, sh; ld_modvec(p, p.norm2_g + l * D, l, cond, 1, lane, a, sh);
        for (int r = gw; r < n; r += NGW) { const int row = r0 + r;
            RowVec x = ld_row_f32(X1 + (size_t)row * D, lane); const float rs = row_rs(x);
#pragma unroll
            for (int j = 0; j < 4; ++j) x.v[j] = x.v[j] * rs * a.v[j] + sh.v[j];
            st_row_bf16(Hb + (size_t)row * D, lane, x);
            float lg[32];
#pragma unroll
            for (int e = 0; e < 32; ++e) lg[e] = 0.f;
#pragma unroll
            for (int j = 0; j < 4; ++j)
#pragma unroll
                for (int i = 0; i < 4; ++i) { const float h = x.v[j][i]; const LAS float* wrow = wr + (i * 256 + j * 64 + lane) * WR_PITCH;
#pragma unroll
                    for (int q = 0; q < 8; ++q) { const f32x4 w4 = *(const LAS f32x4*)(wrow + q * 4);
                        lg[q * 4 + 0] += h * w4.x; lg[q * 4 + 1] += h * w4.y; lg[q * 4 + 2] += h * w4.z; lg[q * 4 + 3] += h * w4.w; }
                    asm volatile("" ::: "memory"); }
            float t16[16], t8[8], t4[4], t2[2], t1;
            { const bool hi = (lane & 32) != 0;
#pragma unroll
              for (int i = 0; i < 16; ++i) { const float send = hi ? lg[i] : lg[i + 16]; const float recv = __shfl_xor(send, 32); t16[i] = (hi ? lg[i + 16] : lg[i]) + recv; } }
            { const bool hi = (lane & 16) != 0;
#pragma unroll
              for (int i = 0; i < 8; ++i) { const float send = hi ? t16[i] : t16[i + 8]; const float recv = __shfl_xor(send, 16); t8[i] = (hi ? t16[i + 8] : t16[i]) + recv; } }
            { const bool hi = (lane & 8) != 0;
#pragma unroll
              for (int i = 0; i < 4; ++i) { const float send = hi ? t8[i] : t8[i + 4]; const float recv = __shfl_xor(send, 8); t4[i] = (hi ? t8[i + 4] : t8[i]) + recv; } }
            { const bool hi = (lane & 4) != 0;
#pragma unroll
              for (int i = 0; i < 2; ++i) { const float send = hi ? t4[i] : t4[i + 2]; const float recv = __shfl_xor(send, 4); t2[i] = (hi ? t4[i + 2] : t4[i]) + recv; } }
            { const bool hi = (lane & 2) != 0; const float send = hi ? t2[0] : t2[1]; const float recv = __shfl_xor(send, 2); t1 = (hi ? t2[1] : t2[0]) + recv; }
            t1 += __shfl_xor(t1, 1);
            float val = t1 + my_b;
            float tv[4]; int te[4];
#pragma unroll
            for (int k = 0; k < 4; ++k) { float bv = val; int bi = my_e;
#pragma unroll
                for (int o = 1; o < 64; o <<= 1) { const float ov = __shfl_xor(bv, o); const int oi = __shfl_xor(bi, o); if (ov > bv || (ov == bv && oi < bi)) { bv = ov; bi = oi; } }
                tv[k] = bv; te[k] = bi; if (my_e == bi) val = -3.0e38f; }
            const float e1 = __expf(tv[1] - tv[0]), e2 = __expf(tv[2] - tv[0]), e3 = __expf(tv[3] - tv[0]); const float inv = 1.f / (1.f + e1 + e2 + e3);
            if (lane < 4) { const int ek = lane == 0 ? te[0] : lane == 1 ? te[1] : lane == 2 ? te[2] : te[3];
                const float gk = (lane == 0 ? 1.f : lane == 1 ? e1 : lane == 2 ? e2 : e3) * inv;
                const int pos = atomicAdd(cnt + ek, 1); const int tokm = row - tokbase;
                list[(size_t)ek * NTOK + pos] = row; asg_e[tokm * 4 + lane] = ek; asg_p[tokm * 4 + lane] = pos; gate[tokm * 4 + lane] = gk; }
        } }
}

__device__ __forceinline__ void ph_combine(const P& p, int l) {
    const int tid = threadIdx.x, lane = tid & 63, gw = blockIdx.x * 8 + (tid >> 6), NGW = gridDim.x * 8;
    const int* cnt = (const int*)(p.ws + CTL_CNT) + l * NE;
    int ps; { const int c = cnt[lane & 31]; const int pc = (c + 255) & ~255; int incl = pc;
#pragma unroll
        for (int o = 1; o < 32; o <<= 1) { const int t = __shfl_up(incl, o); if ((lane & 31) >= o) incl += t; }
        ps = incl - pc; }
    const int* asg_e = (const int*)(p.ws + WS_ROUTE + RT_ASGE); const int* asg_p = (const int*)(p.ws + WS_ROUTE + RT_ASGP); const float* gate = (const float*)(p.ws + WS_ROUTE + RT_GATE);
    const bf16_t* Yb = (const bf16_t*)(p.ws + WS_YB); const float* X1 = (const float*)(p.ws + WS_X1); float* X2 = (float*)(p.ws + WS_X2); bf16_t* Hb = (bf16_t*)(p.ws + WS_HB);
    const int tokbase = (l == 0) ? 0 : NCTX;
    for (int s = (l == 0 ? 0 : 1); s < 3; ++s) { int r0, n, cond; seg_range(s, r0, n, cond);
        const RowVec g2 = ld_row_f32(modp(p, l, cond, 5), lane); RowVec a, sh;
        if (l == 0) ld_modvec(p, p.norm1_g + D, 1, cond, 0, lane, a, sh); else { a = ld_row_f32(p.final_g, lane); }
        for (int r = gw; r < n; r += NGW) { const int row = r0 + r, tokm = row - tokbase;
            RowVec y;
#pragma unroll
            for (int j = 0; j < 4; ++j) y.v[j] = (f32x4){0.f, 0.f, 0.f, 0.f};
#pragma unroll
            for (int k = 0; k < 4; ++k) { const int e = asg_e[tokm * 4 + k], pos = asg_p[tokm * 4 + k]; const float gk = gate[tokm * 4 + k];
                const int prow = __shfl(ps, e) + pos; const bf16_t* yr = Yb + (size_t)prow * D;
#pragma unroll
                for (int j = 0; j < 4; ++j) { const u32x2 w = *(const u32x2*)(yr + 256 * j + 4 * lane);
                    y.v[j].x += gk * bf2f(w.x & 0xffffu); y.v[j].y += gk * bf2f(w.x >> 16); y.v[j].z += gk * bf2f(w.y & 0xffffu); y.v[j].w += gk * bf2f(w.y >> 16); } }
            RowVec x = ld_row_f32(X1 + (size_t)row * D, lane);
#pragma unroll
            for (int j = 0; j < 4; ++j) x.v[j] = x.v[j] + g2.v[j] * y.v[j];
            const float rs = row_rs(x);
            if (l == 0) { st_row_f32(X2 + (size_t)row * D, lane, x);
#pragma unroll
                for (int j = 0; j < 4; ++j) x.v[j] = x.v[j] * rs * a.v[j] + sh.v[j];
                st_row_bf16(Hb + (size_t)row * D, lane, x); }
            else {
#pragma unroll
                for (int j = 0; j < 4; ++j) x.v[j] = x.v[j] * rs * a.v[j];
                st_row_f32(p.out + (size_t)(row - NCTX) * D, lane, x); }
        } }
}

__device__ __forceinline__ void moe_tables(const P& p, int l, LAS int* tb) {
    __syncthreads();
    if (threadIdx.x < 64) { const int lane = threadIdx.x; const int c = ((const int*)(p.ws + CTL_CNT))[l * NE + (lane & 31)]; const int pc = (c + 255) & ~255; int incl = pc;
#pragma unroll
        for (int o = 1; o < 32; o <<= 1) { const int t = __shfl_up(incl, o); if ((lane & 31) >= o) incl += t; }
        if (lane < 32) { tb[lane] = incl - pc; tb[64 + lane] = (incl - pc) >> 8; tb[128 + lane] = c; if (lane == 31) { tb[32] = incl; tb[96] = incl >> 8; } } }
    __syncthreads();
}
struct RowsGather { const bf16_t* Hb; const int* list; int base, cnt, dummy;
    __device__ __forceinline__ const bf16_t* row(int i) const { const int idx = base + i; const int r = idx < cnt ? list[idx] : dummy; return Hb + (size_t)r * D; } };
struct RowsW1 { const bf16_t* w; int pn;
    __device__ __forceinline__ const bf16_t* row(int j) const { const int wc = j >> 6, jj = j & 63; return w + (size_t)(((jj >> 5) & 1) * DFF + pn * 128 + wc * 32 + (jj & 31)) * D; } };

__device__ __forceinline__ void ph_moe1(const P& p, int l, LAS unsigned char* lds) {
    LAS int* tb = (LAS int*)lds; moe_tables(p, l, tb);
    const int nblk = tb[96]; const int nunits = nblk * 16;
    const bf16_t* Hb = (const bf16_t*)(p.ws + WS_HB); const int* list = (const int*)(p.ws + WS_ROUTE + RT_LIST); bf16_t* Act = (bf16_t*)(p.ws + WS_ACT);
    for (int u = blockIdx.x; u < nunits; u += gridDim.x) { const int rbi = u >> 4, hm = (u >> 3) & 1, pn = u & 7;
        int e = 0;
#pragma unroll 1
        for (int i = 1; i < 32; ++i) if (tb[64 + i] <= rbi) e = i;
        const int rb = rbi - tb[64 + e], c = tb[128 + e], base = rb * 256 + hm * 128;
        if (base >= c) continue;
        RowsGather af{Hb, list + (size_t)e * NTOK, base, c, (l == 0) ? 0 : NCTX};
        RowsW1 bf{(const bf16_t*)(p.ws + WS_W1T) + (size_t)(l * NE + e) * 2 * DFF * D, pn};
        EpiSwiglu ef{Act + (size_t)(tb[e] + base) * DFF, p.e_b1 + (size_t)(l * NE + e) * 2 * DFF, pn * 128};
        sgemm_unit(af, bf, ef, D);
    }
}
__device__ __forceinline__ void ph_moe2(const P& p, int l, LAS unsigned char* lds) {
    LAS int* tb = (LAS int*)lds; moe_tables(p, l, tb);
    const int nblk = tb[96]; const int nunits = nblk * 8;
    const bf16_t* Act = (const bf16_t*)(p.ws + WS_ACT); bf16_t* Yb = (bf16_t*)(p.ws + WS_YB);
    for (int u = blockIdx.x; u < nunits; u += gridDim.x) { const int rbi = u >> 3, hm = (u >> 2) & 1, pn = u & 3;
        int e = 0;
#pragma unroll 1
        for (int i = 1; i < 32; ++i) if (tb[64 + i] <= rbi) e = i;
        const int rb = rbi - tb[64 + e], c = tb[128 + e], base = rb * 256 + hm * 128;
        if (base >= c) continue;
        const size_t prow = (size_t)(tb[e] + base);
        RowsDense af{Act + prow * DFF, DFF};
        RowsDense bf{(const bf16_t*)(p.ws + WS_W2T) + (size_t)(l * NE + e) * D * DFF + (size_t)pn * 256 * DFF, DFF};
        EpiBias ef{Yb + prow * D, p.e_b2 + (size_t)(l * NE + e) * D, pn * 256};
        sgemm_unit(af, bf, ef, DFF);
    }
}

__device__ __forceinline__ void ph_fprep1(const P& p) {
    for (int u = blockIdx.x; u < 64; u += gridDim.x) { const int type = u >> 5, g = (u >> 3) & 3, mt = u & 7;
        RowsDense af{(const bf16_t*)(p.ws + WS_WINB) + (size_t)(mt * 128) * D + g * 256, D};
        RowsDense bf{(const bf16_t*)(p.ws + WS_TAB + (type ? TAB_S256 : TAB_C256)), 256};
        EpiBf16Plain ef{(bf16_t*)(p.ws + WS_TAB2) + (size_t)(type * D + mt * 128) * D + g * 256, D};
        sgemm_unit(af, bf, ef, 256); }
}
__device__ __forceinline__ void ph_fprep2(const P& p) {
    for (int u = blockIdx.x; u < 64; u += gridDim.x) { const int mt = u >> 3, nt = u & 7;
        RowsDense af{(const bf16_t*)(p.ws + WS_WOUTT) + (size_t)(mt * 128) * D, D};
        RowsDense bf{(const bf16_t*)(p.ws + WS_TAB2) + (size_t)(nt * 256) * D, D};
        EpiBf16Plain ef{(bf16_t*)(p.ws + WS_WABT) + (size_t)(mt * 128) * 2 * D + nt * 256, 2 * D};
        sgemm_unit(af, bf, ef, D); }
}
__device__ __forceinline__ void ph_cdft(const P& p, LAS unsigned char* lds) {
    const bf16_t* Hb = (const bf16_t*)(p.ws + WS_HB); bf16_t* Z1 = (bf16_t*)(p.ws + WS_Z1); bf16_t* Z = (bf16_t*)(p.ws + WS_Z);
    const bf16_t* tb = (const bf16_t*)(p.ws + WS_TAB);
    for (int u = blockIdx.x; u < 32 + 4096; u += gridDim.x) {
        if (u < 32) { const int b = u >> 4, cb = u & 15;
            dft_unit<256, false>(lds, Hb + (size_t)(b * CTXL) * D + cb * 64, nullptr, D, tb + TAB_T256 / 2, nullptr, Z + (size_t)(b * CTXL) * 2 * D + cb * 64, 2 * D); }
        else { const int v = u - 32, b = v >> 11, r = (v >> 4) & 127, cb = v & 15;
            dft_unit<64, false>(lds, Hb + (size_t)(NCTX + b * SEQ + r * 64) * D + cb * 64, nullptr, D, tb + TAB_T64 / 2, nullptr,
                                Z1 + (size_t)(NCTX + b * SEQ + r) * 2 * D + cb * 64, (size_t)128 * 2 * D); }
    }
}
__device__ __forceinline__ void ph_rdft(const P& p, LAS unsigned char* lds) {
    const bf16_t* Z1 = (const bf16_t*)(p.ws + WS_Z1); bf16_t* Z = (bf16_t*)(p.ws + WS_Z); const bf16_t* tb = (const bf16_t*)(p.ws + WS_TAB);
    for (int u = blockIdx.x; u < 2048; u += gridDim.x) { const int b = u >> 10, cc = (u >> 4) & 63, cb = u & 15;
        const size_t r0 = (size_t)(NCTX + b * SEQ + cc * 128);
        dft_unit<128, true>(lds, Z1 + r0 * 2 * D + cb * 64, Z1 + r0 * 2 * D + D + cb * 64, 2 * D, tb + TAB_T128A / 2, tb + TAB_T128B / 2, Z + r0 * 2 * D + cb * 64, 2 * D); }
}
__device__ __forceinline__ void ph_gemm_f(const P& p) {
    for (int u = blockIdx.x; u < 132 * 4; u += gridDim.x) { const int mt = u >> 2, nt = u & 3;
        RowsDense af{(const bf16_t*)(p.ws + WS_Z) + (size_t)(mt * 128) * 2 * D, 2 * D};
        RowsDense bf{(const bf16_t*)(p.ws + WS_WABT) + (size_t)(nt * 256) * 2 * D, 2 * D};
        EpiResidual<true> ef{&p, mt * 128, nt * 256, 0};
        sgemm_unit(af, bf, ef, 2 * D); }
}

__device__ __forceinline__ void ph_gemm_hi(const P& p) {
    for (int u = blockIdx.x; u < 132 * 20; u += gridDim.x) { const int mt = u / 20, nt = u % 20;
        RowsDense af{(const bf16_t*)(p.ws + WS_HB) + (size_t)(mt * 128) * D, D};
        RowsDense bf{(const bf16_t*)(p.ws + WS_WHIT) + (size_t)(nt * 256) * D, D};
        EpiHgrnIn ef{&p, mt * 128, nt * 256};
        sgemm_unit(af, bf, ef, D); }
}
__device__ __forceinline__ void ph_gemm_ho(const P& p) {
    for (int u = blockIdx.x; u < 128 * 4; u += gridDim.x) { const int mt = u >> 2, nt = u & 3;
        RowsDense af{(const bf16_t*)(p.ws + WS_YR) + (size_t)(mt * 128) * D, D};
        RowsDense bf{(const bf16_t*)(p.ws + WS_WHOT) + (size_t)(nt * 256) * D, D};
        EpiResidual<false> ef{&p, NCTX + mt * 128, nt * 256, 1};
        sgemm_unit(af, bf, ef, D); }
}
__device__ __forceinline__ int scan_row(int b, int dir, int ps) {
    if (ps < CTXL) return b * CTXL + (dir ? CTXL - 1 - ps : ps);
    const int q = ps - CTXL; return NCTX + b * SEQ + (dir ? SEQ - 1 - q : q);
}
constexpr int SCAN_TB = 16;
template <bool OUTPUT>
__device__ __forceinline__ void scan_unit(const P& p, int unit, LAS unsigned char* lds) {
    const int tid = threadIdx.x, lane = tid & 63, wave = tid >> 6, kgrp = lane & 31, vgrp = wave * 2 + (lane >> 5);
    const int stream = unit >> 3, part = unit & 7, b = stream >> 4, h = (stream >> 1) & 7, dir = stream & 1;
    LAS float* F = (LAS float*)lds; LAS float* KK = F + SCAN_TB * 128; LAS float* VV = KK + SCAN_TB * 128; LAS float* QQ = VV + SCAN_TB * 128; LAS float* OB = QQ + SCAN_TB * 128;
    const bf16_t* Kb = (const bf16_t*)(p.ws + (dir ? WS_KBW : WS_KFW)); const float* Ab = (const float*)(p.ws + (dir ? WS_ABW : WS_AFW));
    const bf16_t* Vb = (const bf16_t*)(p.ws + WS_VB); const bf16_t* Qb = (const bf16_t*)(p.ws + WS_QB);
    float* Sloc = (float*)(p.ws + WS_SLOC); float* Dsum = (float*)(p.ws + WS_DSUM);
    float S[4][8]; float ds[4];
#pragma unroll
    for (int i = 0; i < 4; ++i) { ds[i] = 0.f;
#pragma unroll
        for (int j = 0; j < 8; ++j) S[i][j] = 0.f; }
    int p0, p1;
    if (!OUTPUT) { if (part == 0) { p0 = 0; p1 = CTXL; } else { p0 = CTXL + (part - 1) * 1024; p1 = p0 + 1024; } }
    else { p0 = CTXL + part * 1024; p1 = p0 + 1024;
        for (int u = 0; u <= part; ++u) { const float* sl = Sloc + ((size_t)(stream * 8 + u) * 128) * 128; const float* dd = Dsum + (size_t)(stream * 8 + u) * 128;
#pragma unroll
            for (int i = 0; i < 4; ++i) { const int k = 4 * kgrp + i; const float dec = __expf(dd[k]); const f32x4 s0 = *(const f32x4*)(sl + (size_t)k * 128 + 8 * vgrp), s1 = *(const f32x4*)(sl + (size_t)k * 128 + 8 * vgrp + 4);
                S[i][0] = dec * S[i][0] + s0.x; S[i][1] = dec * S[i][1] + s0.y; S[i][2] = dec * S[i][2] + s0.z; S[i][3] = dec * S[i][3] + s0.w;
                S[i][4] = dec * S[i][4] + s1.x; S[i][5] = dec * S[i][5] + s1.y; S[i][6] = dec * S[i][6] + s1.z; S[i][7] = dec * S[i][7] + s1.w; } } }
    for (int pb = p0; pb < p1; pb += SCAN_TB) {
        __syncthreads();
#pragma unroll
        for (int q = 0; q < SCAN_TB * 128 / 512; ++q) { const int e = tid + 512 * q, t = e >> 7, ch = e & 127; const size_t g = (size_t)scan_row(b, dir, pb + t) * D + h * HD + ch;
            const float a = Ab[g]; F[e] = OUTPUT ? __expf(a) : a; KK[e] = bf2f(Kb[g]); VV[e] = bf2f(Vb[g]); if (OUTPUT) QQ[e] = bf2f(Qb[g]); }
        __syncthreads();
#pragma unroll 1
        for (int t = 0; t < SCAN_TB; ++t) {
            const f32x4 f4 = *(const LAS f32x4*)(F + t * 128 + 4 * kgrp), k4 = *(const LAS f32x4*)(KK + t * 128 + 4 * kgrp);
            const f32x4 v0 = *(const LAS f32x4*)(VV + t * 128 + 8 * vgrp), v1 = *(const LAS f32x4*)(VV + t * 128 + 8 * vgrp + 4);
            const float vv[8] = {v0.x, v0.y, v0.z, v0.w, v1.x, v1.y, v1.z, v1.w};
            if (!OUTPUT) {
#pragma unroll
                for (int i = 0; i < 4; ++i) { const float f = __expf(f4[i]); ds[i] += f4[i];
#pragma unroll
                    for (int j = 0; j < 8; ++j) S[i][j] = f * S[i][j] + k4[i] * vv[j]; }
            } else {
                const f32x4 q4 = *(const LAS f32x4*)(QQ + t * 128 + 4 * kgrp);
                float o[8];
#pragma unroll
                for (int j = 0; j < 8; ++j) o[j] = 0.f;
#pragma unroll
                for (int i = 0; i < 4; ++i) {
#pragma unroll
                    for (int j = 0; j < 8; ++j) { S[i][j] = f4[i] * S[i][j] + k4[i] * vv[j]; o[j] += q4[i] * S[i][j]; } }
                float o4[4], o2[2], o1;
                { const bool hi = (lane & 16) != 0;
#pragma unroll
                  for (int j = 0; j < 4; ++j) { const float send = hi ? o[j] : o[j + 4]; const float recv = __shfl_xor(send, 16); o4[j] = (hi ? o[j + 4] : o[j]) + recv; } }
                { const bool hi = (lane & 8) != 0;
#pragma unroll
                  for (int j = 0; j < 2; ++j) { const float send = hi ? o4[j] : o4[j + 2]; const float recv = __shfl_xor(send, 8); o2[j] = (hi ? o4[j + 2] : o4[j]) + recv; } }
                { const bool hi = (lane & 4) != 0; const float send = hi ? o2[0] : o2[1]; const float recv = __shfl_xor(send, 4); o1 = (hi ? o2[1] : o2[0]) + recv; }
                o1 += __shfl_xor(o1, 2); o1 += __shfl_xor(o1, 1);
                if ((lane & 3) == 0) { const int j = ((lane >> 4) & 1) * 4 + ((lane >> 3) & 1) * 2 + ((lane >> 2) & 1); OB[t * 128 + 8 * vgrp + j] = o1; }
            }
        }
        if (OUTPUT) { __syncthreads(); bf16_t* Ob = (bf16_t*)(p.ws + (dir ? WS_OBW : WS_OFW));
#pragma unroll
            for (int q = 0; q < SCAN_TB * 128 / 512; ++q) { const int e = tid + 512 * q, t = e >> 7, ch = e & 127; const int row = scan_row(b, dir, pb + t) - NCTX;
                Ob[(size_t)row * D + h * HD + ch] = (bf16_t)f2bf(OB[e]); } }
    }
    if (!OUTPUT) { float* sl = Sloc + ((size_t)(stream * 8 + part) * 128) * 128;
#pragma unroll
        for (int i = 0; i < 4; ++i) { const int k = 4 * kgrp + i; *(f32x4*)(sl + (size_t)k * 128 + 8 * vgrp) = (f32x4){S[i][0], S[i][1], S[i][2], S[i][3]}; *(f32x4*)(sl + (size_t)k * 128 + 8 * vgrp + 4) = (f32x4){S[i][4], S[i][5], S[i][6], S[i][7]};
            if (vgrp == 0) Dsum[(size_t)(stream * 8 + part) * 128 + k] = ds[i]; } }
}
__device__ __forceinline__ void ph_readout(const P& p) {
    const int lane = threadIdx.x & 63, gw = blockIdx.x * 8 + (threadIdx.x >> 6), NGW = gridDim.x * 8;
    const bf16_t* Of = (const bf16_t*)(p.ws + WS_OFW); const bf16_t* Ob = (const bf16_t*)(p.ws + WS_OBW); const bf16_t* SG = (const bf16_t*)(p.ws + WS_SGB); bf16_t* Yr = (bf16_t*)(p.ws + WS_YR);
    const RowVec ng = ld_row_f32(p.h_norm_g, lane);
    for (int r = gw; r < NLAT; r += NGW) { RowVec o;
#pragma unroll
        for (int j = 0; j < 4; ++j) { const size_t off = (size_t)r * D + 256 * j + 4 * lane; const u32x2 a = *(const u32x2*)(Of + off), c = *(const u32x2*)(Ob + off), g = *(const u32x2*)(SG + (size_t)NCTX * D + off);
            f32x4 v; v.x = bf2f(a.x & 0xffffu) + bf2f(c.x & 0xffffu); v.y = bf2f(a.x >> 16) + bf2f(c.x >> 16); v.z = bf2f(a.y & 0xffffu) + bf2f(c.y & 0xffffu); v.w = bf2f(a.y >> 16) + bf2f(c.y >> 16);
            float s = (v.x * v.x + v.y * v.y) + (v.z * v.z + v.w * v.w);
#pragma unroll
            for (int q = 1; q < 32; q <<= 1) s += __shfl_xor(s, q);
            const float rs = rsqrtf(s * (1.f / HD) + EPS);
            f32x4 gg; gg.x = bf2f(g.x & 0xffffu); gg.y = bf2f(g.x >> 16); gg.z = bf2f(g.y & 0xffffu); gg.w = bf2f(g.y >> 16);
            o.v[j] = v * rs * ng.v[j] * gg; }
        st_row_bf16(Yr + (size_t)r * D, lane, o); }
}

__global__ void __launch_bounds__(512, 2) fwd(Args args) {
    extern __shared__ __attribute__((aligned(16))) unsigned char lds_raw[];
    LAS unsigned char* lds = (LAS unsigned char*)lds_raw;
    P p;
    p.x = (const float*)args.in[0]; p.c = (const float*)args.in[1]; p.ctx = (const float*)args.in[2]; p.c_ctx = (const float*)args.in[3];
    p.mod_w = (const float*)args.in[4]; p.mod_b = (const float*)args.in[5]; p.norm1_g = (const float*)args.in[6]; p.norm2_g = (const float*)args.in[7];
    p.f_w_in = (const float*)args.in[8]; p.f_w_out = (const float*)args.in[9]; p.h_w_in = (const float*)args.in[10]; p.h_lb = (const float*)args.in[11];
    p.h_norm_g = (const float*)args.in[12]; p.h_w_out = (const float*)args.in[13]; p.router_w = (const float*)args.in[14]; p.router_b = (const float*)args.in[15];
    p.e_w1 = (const float*)args.in[16]; p.e_b1 = (const float*)args.in[17]; p.e_w2 = (const float*)args.in[18]; p.e_b2 = (const float*)args.in[19]; p.final_g = (const float*)args.in[20];
    p.out = args.out; p.ws = args.ws;
    const int lo = args.ph_lo, hi = args.ph_hi;
#define IN(k) (lo <= (k) && (k) < hi)
    if (IN(0)) ph_prologue(p, lds);
    if (IN(1)) { ph_mod1_l0(p); ph_fprep1(p); }
    if (IN(2)) { ph_cdft(p, lds); ph_fprep2(p); }
    if (IN(3)) ph_rdft(p, lds);
    if (IN(4)) ph_gemm_f(p);
    if (IN(5)) ph_mod2_route(p, 0, lds);
    if (IN(6)) ph_moe1(p, 0, lds);
    if (IN(7)) ph_moe2(p, 0, lds);
    if (IN(8)) ph_combine(p, 0);
    if (IN(9)) ph_gemm_hi(p);
    if (IN(10)) { for (int u = blockIdx.x; u < 256; u += gridDim.x) scan_unit<false>(p, u, lds); }
    if (IN(11)) { for (int u = blockIdx.x; u < 256; u += gridDim.x) scan_unit<true>(p, u, lds); }
    if (IN(12)) ph_readout(p);
    if (IN(13)) ph_gemm_ho(p);
    if (IN(14)) ph_mod2_route(p, 1, lds);
    if (IN(15)) ph_moe1(p, 1, lds);
    if (IN(16)) ph_moe2(p, 1, lds);
    if (IN(17)) ph_combine(p, 1);
#undef IN
}

extern "C" void kernel_launch(void* const* d_in, const int* in_sizes, int n_in, void* d_out, int out_size, void* d_ws, size_t ws_size, hipStream_t stream) {
    static int grid = 0;
    if (grid == 0) {
        if (n_in != 21 || out_size != NLAT * D || ws_size < WS_END) { fprintf(stderr, "kernel_launch: unexpected shapes (n_in %d out %d ws %zu)\n", n_in, out_size, ws_size); grid = -1; return; }
        int dev = 0, cus = 0;
        hipGetDevice(&dev); hipDeviceGetAttribute(&cus, hipDeviceAttributeMultiprocessorCount, dev);
        if (hipFuncSetAttribute((const void*)fwd, hipFuncAttributeMaxDynamicSharedMemorySize, LDS_BYTES) != hipSuccess) { fprintf(stderr, "kernel_launch: hipFuncSetAttribute failed\n"); grid = -1; return; }
        grid = cus > 0 ? cus : 256;
    }
    if (grid < 0) return;
    hipMemsetAsync((char*)d_ws + WS_CTL, 0, CTL_BYTES, stream);
    Args a{};
    for (int i = 0; i < 21; ++i) a.in[i] = d_in[i];
    a.out = (float*)d_out; a.ws = (unsigned char*)d_ws;
    for (int ph = 0; ph < NPH; ++ph) { a.ph_lo = ph; a.ph_hi = ph + 1; hipLaunchKernelGGL(fwd, dim3(grid), dim3(512), LDS_BYTES, stream, a); }
}
```

```cpp
#include <hip/hip_runtime.h>
#include <cstdio>
#include <cstdint>

#define LAS __attribute__((address_space(3)))
typedef unsigned short bf16_t;
typedef short bf16x8 __attribute__((ext_vector_type(8)));
typedef float f32x4 __attribute__((ext_vector_type(4)));
typedef float f32x2 __attribute__((ext_vector_type(2)));
typedef unsigned u32x4 __attribute__((ext_vector_type(4)));
typedef unsigned u32x2 __attribute__((ext_vector_type(2)));

constexpr int D = 1024, NBATCH = 2, SEQ = 8192, CTXL = 256;
constexpr int NCTX = NBATCH * CTXL;
constexpr int NLAT = NBATCH * SEQ;
constexpr int NTOK = NCTX + NLAT;
constexpr int NE = 32, DFF = 1024, NH = 8, HD = 128;
constexpr int NHI = 5 * D;
constexpr int MAXROWS = (((NTOK * 4) + 255) / 256 + NE) * 256;
constexpr float EPS = 1e-6f;
constexpr int NPH = 18;

constexpr size_t MiB = 1u << 20;
constexpr size_t WS_CTL = 0, CTL_BYTES = 16384 + 16384;
constexpr size_t CTL_CNT = 16384;
constexpr int CNT_STRIDE = 64;
constexpr size_t CTL_MOD = 128 * 1024;
constexpr size_t WS_LB = 1 * MiB;
constexpr size_t WS_TAB = 2 * MiB;
constexpr size_t TAB_T64 = 0, TAB_T128A = 16384, TAB_T128B = TAB_T128A + 65536, TAB_T256 = TAB_T128B + 65536,
                 TAB_C256 = TAB_T256 + 262144, TAB_S256 = TAB_C256 + 131072;
constexpr size_t WS_WINB = 4 * MiB, WS_WOUTT = 6 * MiB, WS_TAB2 = 8 * MiB, WS_WABT = 12 * MiB, WS_WHIT = 16 * MiB, WS_WHOT = 26 * MiB;
constexpr size_t WS_ROUTE = 28 * MiB;
constexpr size_t RT_LIST = 0, RT_ASGE = 2304 * 1024, RT_ASGP = RT_ASGE + 320 * 1024, RT_GATE = RT_ASGP + 320 * 1024;
constexpr size_t WS_W1T = 32 * MiB, WS_W2T = 288 * MiB;
constexpr size_t WS_HB = 416 * MiB, WS_X1 = 450 * MiB, WS_X2 = 516 * MiB, WS_Z1 = 582 * MiB, WS_Z = 648 * MiB;
constexpr size_t WS_ACT = 714 * MiB, WS_YB = 862 * MiB;
constexpr size_t WS_QB = 1010 * MiB, WS_KFW = 1044 * MiB, WS_KBW = 1078 * MiB, WS_VB = 1112 * MiB, WS_SGB = 1146 * MiB;
constexpr size_t WS_AFW = 1180 * MiB, WS_ABW = 1246 * MiB, WS_OFW = 1312 * MiB, WS_OBW = 1344 * MiB, WS_YR = 1376 * MiB;
constexpr size_t WS_HB8 = WS_KFW;
constexpr size_t WS_WHIT8 = WS_KBW;
constexpr size_t WS_HBH8 = WS_KBW + 8 * MiB;
constexpr size_t WS_SLOC = 1408 * MiB, WS_DSUM = 1424 * MiB, WS_END = 1426 * MiB;

constexpr int LDS_BYTES = 160 * 1024;
constexpr int LDS_MISC = LDS_BYTES - 1024;

struct P {
    const float *x, *c, *ctx, *c_ctx, *mod_w, *mod_b, *norm1_g, *norm2_g, *f_w_in, *f_w_out, *h_w_in, *h_lb, *h_norm_g, *h_w_out,
                *router_w, *router_b, *e_w1, *e_b1, *e_w2, *e_b2, *final_g;
    float* out; unsigned char* ws;
};
struct Args { float* out; unsigned char* ws; const void* in[21]; int ph_lo, ph_hi; };

typedef __bf16 bf16v2 __attribute__((ext_vector_type(2)));
__device__ __forceinline__ unsigned pk2(float lo, float hi) { const bf16v2 v = {(__bf16)lo, (__bf16)hi}; return __builtin_bit_cast(unsigned, v); }
__device__ __forceinline__ unsigned f2bf(float f) { return pk2(f, 0.f) & 0xffffu; }
__device__ __forceinline__ float bf2f(unsigned b) { return __uint_as_float(b << 16); }
__device__ __forceinline__ float sigmoidf_(float v) { return 1.f / (1.f + __expf(-v)); }
__device__ __forceinline__ float siluf_(float v) { return v / (1.f + __expf(-v)); }
__device__ __forceinline__ float wave_sum(float v) {
#pragma unroll
    for (int o = 1; o < 64; o <<= 1) v += __shfl_xor(v, o);
    return v;
}
#define LDS_WAIT() asm volatile("s_waitcnt lgkmcnt(0)" ::: "memory")
__device__ __forceinline__ int opaque_tid() { int t = threadIdx.x; asm volatile("" : "+v"(t)); return t; }
#define TIDX opaque_tid()
__device__ __forceinline__ void lds_barrier() { asm volatile("s_waitcnt lgkmcnt(0)" ::: "memory"); __builtin_amdgcn_s_barrier(); asm volatile("" ::: "memory"); }
constexpr float W_SCALE = 64.f, ACT_SCALE = 4.f;
__device__ __forceinline__ unsigned pk4_fp8(float a, float b, float c, float d) { int w = 0; w = __builtin_amdgcn_cvt_pk_fp8_f32(a, b, w, false); w = __builtin_amdgcn_cvt_pk_fp8_f32(c, d, w, true); return (unsigned)w; }

__device__ __forceinline__ const float* modp(const P& p, int l, int c, int q) { return (const float*)(p.ws + CTL_MOD) + ((size_t)(l * 3 + c) * 6 + q) * D; }
__device__ __forceinline__ int row_cond(int row) { return row < NCTX ? 2 : ((row - NCTX) >> 13); }

__device__ __forceinline__ void transpose_item(const float* W, int K, int N, bf16_t* WT, LAS float* scr, int item, int lane) {
    const int nblk = N / 32, kb = item / nblk, nb = item % nblk, k0 = 64 * kb, n0 = 32 * nb;
#pragma unroll 8
    for (int i = 0; i < 32; ++i) { const int kk = 2 * i + (lane >> 5); scr[kk * 33 + (lane & 31)] = W[(size_t)(k0 + kk) * N + n0 + (lane & 31)]; }
    LDS_WAIT();
    const int c = lane & 7;
#pragma unroll
    for (int j = 0; j < 4; ++j) { const int n = (lane >> 3) + 8 * j; const LAS float* s = scr + (8 * c) * 33 + n;
        u32x4 o; o.x = pk2(s[0 * 33], s[1 * 33]); o.y = pk2(s[2 * 33], s[3 * 33]); o.z = pk2(s[4 * 33], s[5 * 33]); o.w = pk2(s[6 * 33], s[7 * 33]);
        *(u32x4*)(WT + (size_t)(n0 + n) * K + k0 + 8 * c) = o; }
    LDS_WAIT();
}

struct CvtRegs { f32x4 v[16]; };
__device__ __forceinline__ void cvt_issue(CvtRegs& r, const float* W, int N, int item, int lane) {
    const int nblk = N / 32, kb = item / nblk, nb = item % nblk; const float* src = W + (size_t)(128 * kb + 16 * (lane >> 3)) * N + 32 * nb + 4 * (lane & 7);
#pragma unroll
    for (int i = 0; i < 16; ++i) r.v[i] = *(const f32x4*)(src + (size_t)i * N);
}
__device__ __forceinline__ void cvt_finish(const CvtRegs& r, unsigned char* WT, int K, int N, int item, int lane) {
    const int nblk = N / 32, kb = item / nblk, nb = item % nblk; unsigned o[4][4];
#pragma unroll
    for (int blk = 0; blk < 4; ++blk) { unsigned d[4];
#pragma unroll
        for (int e = 0; e < 4; ++e) { const f32x4 x = r.v[4 * blk + e] * W_SCALE; d[e] = pk4_fp8(x[0], x[1], x[2], x[3]); }
        const unsigned t0 = __builtin_amdgcn_perm(d[1], d[0], 0x05010400u), t1 = __builtin_amdgcn_perm(d[1], d[0], 0x07030602u);
        const unsigned t2 = __builtin_amdgcn_perm(d[3], d[2], 0x05010400u), t3 = __builtin_amdgcn_perm(d[3], d[2], 0x07030602u);
        o[0][blk] = __builtin_amdgcn_perm(t2, t0, 0x05040100u); o[1][blk] = __builtin_amdgcn_perm(t2, t0, 0x07060302u);
        o[2][blk] = __builtin_amdgcn_perm(t3, t1, 0x05040100u); o[3][blk] = __builtin_amdgcn_perm(t3, t1, 0x07060302u); }
    unsigned char* dst = WT + (size_t)(32 * nb + 4 * (lane & 7)) * K + 128 * kb + 16 * (lane >> 3);
#pragma unroll
    for (int j = 0; j < 4; ++j) *(u32x4*)(dst + (size_t)j * K) = (u32x4){o[j][0], o[j][1], o[j][2], o[j][3]};
}
constexpr int CV_W1 = 8 * 64, CV_W2 = 8 * 32, CV_N1 = 64 * CV_W1, CV_NALL = CV_N1 + 64 * CV_W2;
__device__ __forceinline__ void cvt_item_issue(CvtRegs& r, const P& p, int it, int lane) {
    if (it < CV_N1) cvt_issue(r, p.e_w1 + (size_t)(it / CV_W1) * D * 2 * DFF, 2 * DFF, it % CV_W1, lane);
    else { const int q = it - CV_N1; cvt_issue(r, p.e_w2 + (size_t)(q / CV_W2) * DFF * D, D, q % CV_W2, lane); } }
__device__ __forceinline__ void cvt_item_finish(const CvtRegs& r, const P& p, int it, int lane) {
    if (it < CV_N1) cvt_finish(r, (unsigned char*)(p.ws + WS_W1T) + (size_t)(it / CV_W1) * D * 2 * DFF, D, 2 * DFF, it % CV_W1, lane);
    else { const int q = it - CV_N1; cvt_finish(r, (unsigned char*)(p.ws + WS_W2T) + (size_t)(q / CV_W2) * DFF * D, DFF, D, q % CV_W2, lane); } }

constexpr int BG_ITEMS = 32 * CV_W1 + 32 * CV_W2, BG_SLOTS = 12;
__device__ __forceinline__ int bg_item(int pool, int n) { return n < 32 * CV_W1 ? pool * 32 * CV_W1 + n : CV_N1 + pool * 32 * CV_W2 + (n - 32 * CV_W1); }
__device__ __forceinline__ bool bg_issue(CvtRegs& r, const P& p, int pool, int slot) { const int gw = blockIdx.x * 8 + (TIDX >> 6), n = slot * (int)gridDim.x * 8 + gw;
    if (n >= BG_ITEMS) return false; cvt_item_issue(r, p, bg_item(pool, n), TIDX & 63); return true; }
__device__ __forceinline__ void bg_finish(const CvtRegs& r, const P& p, int pool, int slot) { const int gw = blockIdx.x * 8 + (TIDX >> 6), n = slot * (int)gridDim.x * 8 + gw;
    cvt_item_finish(r, p, bg_item(pool, n), TIDX & 63); }
__device__ __forceinline__ void bg_catchup(const P& p, int pool) { const int NGW = gridDim.x * 8, gw = blockIdx.x * 8 + (TIDX >> 6); CvtRegs r;
    for (int n = BG_SLOTS * NGW + gw; n < BG_ITEMS; n += NGW) { cvt_item_issue(r, p, bg_item(pool, n), TIDX & 63); cvt_item_finish(r, p, bg_item(pool, n), TIDX & 63); } }

__device__ __forceinline__ void ph_prologue(const P& p, LAS unsigned char* lds) {
    const int tid = TIDX, lane = tid & 63, wave = tid >> 6, G = gridDim.x, bid = blockIdx.x;
    {
        LAS float* sc = (LAS float*)lds;
        LAS float* red = sc + 3 * D;
        __syncthreads();
        for (int e = tid; e < 3 * D; e += 512) { const int c = e >> 10, k = e & 1023; const float v = (c < 2) ? p.c[c * D + k] : p.c_ctx[k]; sc[e] = siluf_(v); }
        __syncthreads();
        const int cq = tid & 15, kg = tid >> 4;
        for (int it = bid; it < 192; it += G) {
            const int l = it / 96, cb = it % 96;
            const float* w = p.mod_w + ((size_t)l * D + kg * 32) * 6144 + cb * 64 + 4 * cq;
            f32x4 a0 = {0.f, 0.f, 0.f, 0.f}, a1 = a0, a2 = a0;
#pragma unroll 8
            for (int kk = 0; kk < 32; ++kk) { const f32x4 wv = *(const f32x4*)(w + (size_t)kk * 6144); const int k = kg * 32 + kk;
                a0 += wv * sc[k]; a1 += wv * sc[D + k]; a2 += wv * sc[2 * D + k]; }
            *(LAS f32x4*)(red + (kg * 3 + 0) * 64 + 4 * cq) = a0; *(LAS f32x4*)(red + (kg * 3 + 1) * 64 + 4 * cq) = a1; *(LAS f32x4*)(red + (kg * 3 + 2) * 64 + 4 * cq) = a2;
            __syncthreads();
            if (tid < 192) { const int c = tid >> 6, col = tid & 63; float s = p.mod_b[l * 6144 + cb * 64 + col];
                for (int g2 = 0; g2 < 32; ++g2) s += red[(g2 * 3 + c) * 64 + col];
                ((float*)(p.ws + CTL_MOD))[(size_t)(l * 3 + c) * 6144 + cb * 64 + col] = s; }
            __syncthreads();
        }
    }
    const int gt = bid * 512 + tid, NT = G * 512;
    for (int i = gt; i < 2048; i += NT) ((float*)(p.ws + WS_LB))[i] = sigmoidf_(p.h_lb[2048 + i] - p.h_lb[i]);
    {
        bf16_t* tb = (bf16_t*)(p.ws + WS_TAB);
        for (int e = gt; e < 335872; e += NT) {
            int r = e; float v; bf16_t* dst;
            if (r < 8192) { const int m = r >> 6, k = r & 63; const int mm = m & 63; const float a = 2.f * (float)((mm * k) & 63) / 64.f;
                v = (m < 64 ? cospif(a) : -sinpif(a)) * 0.125f; dst = tb + TAB_T64 / 2 + r; }
            else if ((r -= 8192) < 32768) { const int m = r >> 7, k = r & 127; const int mm = m & 127; const float a = 2.f * (float)((mm * k) & 127) / 128.f;
                v = (m < 128 ? cospif(a) : -sinpif(a)) * 0.08838834764831845f; dst = tb + TAB_T128A / 2 + r; }
            else if ((r -= 32768) < 32768) { const int m = r >> 7, k = r & 127; const int mm = m & 127; const float a = 2.f * (float)((mm * k) & 127) / 128.f;
                v = (m < 128 ? sinpif(a) : cospif(a)) * 0.08838834764831845f; dst = tb + TAB_T128B / 2 + r; }
            else if ((r -= 32768) < 131072) { const int m = r >> 8, k = r & 255; const int mm = m & 255; const float a = 2.f * (float)((mm * k) & 255) / 256.f;
                v = (m < 256 ? cospif(a) : -sinpif(a)) * 0.0625f; dst = tb + TAB_T256 / 2 + r; }
            else if ((r -= 131072) < 65536) { const int m = r >> 8, k = r & 255; const float a = 2.f * (float)((m * k) & 255) / 256.f; v = cospif(a) * 0.0625f; dst = tb + TAB_C256 / 2 + r; }
            else { r -= 65536; const int m = r >> 8, k = r & 255; const float a = 2.f * (float)((m * k) & 255) / 256.f; v = sinpif(a) * 0.0625f; dst = tb + TAB_S256 / 2 + r; }
            *dst = (bf16_t)f2bf(v);
        }
    }
    { bf16_t* wb = (bf16_t*)(p.ws + WS_WINB);
      for (int e = gt; e < D * D / 4; e += NT) { const f32x4 v = ((const f32x4*)p.f_w_in)[e]; u32x2 o; o.x = pk2(v.x, v.y); o.y = pk2(v.z, v.w); ((u32x2*)wb)[e] = o; } }
    {
        LAS float* scr = (LAS float*)(lds + wave * 8704);
        const int gw = bid * 8 + wave, NGW = G * 8;
        constexpr int I_FO = 16 * 32, I_HO = 16 * 32, NIT = I_FO + I_HO;
        for (int it = gw; it < NIT; it += NGW) {
            int r = it;
            if (r < I_FO) { transpose_item(p.f_w_out, D, D, (bf16_t*)(p.ws + WS_WOUTT), scr, r, lane); continue; } r -= I_FO;
            transpose_item(p.h_w_out, D, D, (bf16_t*)(p.ws + WS_WHOT), scr, r, lane);
        }
        { CvtRegs r; for (int it = gw; it < 8 * 160; it += NGW) { cvt_issue(r, p.h_w_in, NHI, it, lane);
              { const int kb = it / 160, nb = it % 160; bf16_t* dst = (bf16_t*)(p.ws + WS_WHIT) + (size_t)(32 * nb + 4 * (lane & 7)) * D + 128 * kb + 16 * (lane >> 3);
#pragma unroll
                for (int j = 0; j < 4; ++j) { u32x4 lo, hi;
#pragma unroll
                    for (int q = 0; q < 4; ++q) { lo[q] = pk2(r.v[2 * q][j], r.v[2 * q + 1][j]); hi[q] = pk2(r.v[8 + 2 * q][j], r.v[8 + 2 * q + 1][j]); }
                    *(u32x4*)(dst + (size_t)j * D) = lo; *(u32x4*)(dst + (size_t)j * D + 8) = hi; } }
              cvt_finish(r, (unsigned char*)(p.ws + WS_WHIT8), D, NHI, it, lane); } }
    }
}

struct RowsDense { const bf16_t* base; size_t ld; __device__ __forceinline__ const bf16_t* row(int i) const { return base + (size_t)i * ld; } };
__device__ __forceinline__ void st_bf4(bf16_t* p, f32x4 v) { u32x2 o; o.x = pk2(v.x, v.y); o.y = pk2(v.z, v.w); *(u32x2*)p = o; }

template <int KD, bool TWO> struct DftRegs { u32x4 v[(KD * 8 + 511) / 512][TWO ? 2 : 1]; };
template <int KD, bool TWO> __device__ __forceinline__ void dft_fetch(DftRegs<KD, TWO>& r, const bf16_t* x1, const bf16_t* x2, size_t xpitch) {
    const int tid = TIDX;
#pragma unroll
    for (int q = 0; q < (KD * 8 + 511) / 512; ++q) { const int e = tid + 512 * q; if (e < KD * 8) { const int k = e >> 3, c8 = (e & 7) * 8;
        r.v[q][0] = *(const u32x4*)(x1 + (size_t)k * xpitch + c8); if (TWO) r.v[q][TWO ? 1 : 0] = *(const u32x4*)(x2 + (size_t)k * xpitch + c8); } }
}
template <int KD, bool TWO> __device__ __forceinline__ void dft_stage(LAS unsigned char* lds, const DftRegs<KD, TWO>& r) {
    constexpr int PITCH = KD + 8; LAS bf16_t* XT1 = (LAS bf16_t*)lds; LAS bf16_t* XT2 = XT1 + 64 * PITCH; const int tid = TIDX;
#pragma unroll
    for (int q = 0; q < (KD * 8 + 511) / 512; ++q) { const int e = tid + 512 * q; if (e < KD * 8) { const int k = e >> 3, c8 = (e & 7) * 8;
        const unsigned w[4] = {r.v[q][0].x, r.v[q][0].y, r.v[q][0].z, r.v[q][0].w};
#pragma unroll
        for (int j = 0; j < 4; ++j) { XT1[(c8 + 2 * j) * PITCH + k] = (bf16_t)(w[j] & 0xffffu); XT1[(c8 + 2 * j + 1) * PITCH + k] = (bf16_t)(w[j] >> 16); }
        if (TWO) { const unsigned w2[4] = {r.v[q][TWO ? 1 : 0].x, r.v[q][TWO ? 1 : 0].y, r.v[q][TWO ? 1 : 0].z, r.v[q][TWO ? 1 : 0].w};
#pragma unroll
            for (int j = 0; j < 4; ++j) { XT2[(c8 + 2 * j) * PITCH + k] = (bf16_t)(w2[j] & 0xffffu); XT2[(c8 + 2 * j + 1) * PITCH + k] = (bf16_t)(w2[j] >> 16); } } } }
}
template <int KD, bool TWO> struct DftT { bf16x8 t[(2 * KD) / 128][KD / 32][TWO ? 2 : 1]; };
template <int KD, bool TWO> __device__ __forceinline__ void dft_load_t(DftT<KD, TWO>& T, const bf16_t* T1, const bf16_t* T2) {
    constexpr int MT = (2 * KD) / 128; const int lane = TIDX & 63, wid = TIDX >> 6, fr = lane & 15, fq = lane >> 4; const int mrow0 = wid * (MT * 16);
#pragma unroll
    for (int mi = 0; mi < MT; ++mi)
#pragma unroll
        for (int ks = 0; ks < KD / 32; ++ks) { T.t[mi][ks][0] = *(const bf16x8*)(T1 + (size_t)(mrow0 + mi * 16 + fr) * KD + ks * 32 + fq * 8);
            if (TWO) T.t[mi][ks][TWO ? 1 : 0] = *(const bf16x8*)(T2 + (size_t)(mrow0 + mi * 16 + fr) * KD + ks * 32 + fq * 8); }
}
template <int KD> __device__ __forceinline__ void dft_compute_stream(LAS unsigned char* lds, const bf16_t* T1, bf16_t* obase, size_t opitch) {
    constexpr int PITCH = KD + 8, MT = (2 * KD) / 128; const LAS bf16_t* XT1 = (const LAS bf16_t*)lds;
    const int lane = TIDX & 63, wid = TIDX >> 6, fr = lane & 15, fq = lane >> 4; const int mrow0 = wid * (MT * 16);
    f32x4 acc[MT][4];
#pragma unroll
    for (int i = 0; i < MT; ++i)
#pragma unroll
        for (int j = 0; j < 4; ++j) acc[i][j] = (f32x4){0.f, 0.f, 0.f, 0.f};
#pragma unroll 2
    for (int ks = 0; ks < KD / 32; ++ks) { bf16x8 xb[4], ta[MT];
#pragma unroll
        for (int mi = 0; mi < MT; ++mi) ta[mi] = *(const bf16x8*)(T1 + (size_t)(mrow0 + mi * 16 + fr) * KD + ks * 32 + fq * 8);
#pragma unroll
        for (int ni = 0; ni < 4; ++ni) xb[ni] = *(const LAS bf16x8*)(XT1 + (ni * 16 + fr) * PITCH + ks * 32 + fq * 8);
#pragma unroll
        for (int mi = 0; mi < MT; ++mi)
#pragma unroll
            for (int ni = 0; ni < 4; ++ni) acc[mi][ni] = __builtin_amdgcn_mfma_f32_16x16x32_bf16(xb[ni], ta[mi], acc[mi][ni], 0, 0, 0); }
#pragma unroll
    for (int mi = 0; mi < MT; ++mi) { const int m = mrow0 + mi * 16 + fr; bf16_t* orow = obase + (size_t)(m % KD) * opitch + (m >= KD ? D : 0);
#pragma unroll
        for (int ni = 0; ni < 4; ++ni) st_bf4(orow + ni * 16 + 4 * fq, acc[mi][ni]); }
}
template <int KD, bool TWO> __device__ __forceinline__ void dft_compute(LAS unsigned char* lds, const DftT<KD, TWO>& T, bf16_t* obase, size_t opitch) {
    constexpr int PITCH = KD + 8, MT = (2 * KD) / 128; const LAS bf16_t* XT1 = (const LAS bf16_t*)lds; const LAS bf16_t* XT2 = XT1 + 64 * PITCH;
    const int lane = TIDX & 63, wid = TIDX >> 6, fr = lane & 15, fq = lane >> 4; const int mrow0 = wid * (MT * 16);
    f32x4 acc[MT][4];
#pragma unroll
    for (int i = 0; i < MT; ++i)
#pragma unroll
        for (int j = 0; j < 4; ++j) acc[i][j] = (f32x4){0.f, 0.f, 0.f, 0.f};
#pragma unroll
    for (int ks = 0; ks < KD / 32; ++ks) { bf16x8 xb[4];
#pragma unroll
        for (int ni = 0; ni < 4; ++ni) xb[ni] = *(const LAS bf16x8*)(XT1 + (ni * 16 + fr) * PITCH + ks * 32 + fq * 8);
#pragma unroll
        for (int mi = 0; mi < MT; ++mi)
#pragma unroll
            for (int ni = 0; ni < 4; ++ni) acc[mi][ni] = __builtin_amdgcn_mfma_f32_16x16x32_bf16(xb[ni], T.t[mi][ks][0], acc[mi][ni], 0, 0, 0);
        if (TWO) {
#pragma unroll
            for (int ni = 0; ni < 4; ++ni) xb[ni] = *(const LAS bf16x8*)(XT2 + (ni * 16 + fr) * PITCH + ks * 32 + fq * 8);
#pragma unroll
            for (int mi = 0; mi < MT; ++mi)
#pragma unroll
                for (int ni = 0; ni < 4; ++ni) acc[mi][ni] = __builtin_amdgcn_mfma_f32_16x16x32_bf16(xb[ni], T.t[mi][ks][TWO ? 1 : 0], acc[mi][ni], 0, 0, 0); } }
#pragma unroll
    for (int mi = 0; mi < MT; ++mi) { const int m = mrow0 + mi * 16 + fr; bf16_t* orow = obase + (size_t)(m % KD) * opitch + (m >= KD ? D : 0);
#pragma unroll
        for (int ni = 0; ni < 4; ++ni) st_bf4(orow + ni * 16 + 4 * fq, acc[mi][ni]); }
}

struct RowVec { f32x4 v[4]; };
__device__ __forceinline__ RowVec ld_row_f32(const float* r, int lane) { RowVec o;
#pragma unroll
    for (int j = 0; j < 4; ++j) o.v[j] = *(const f32x4*)(r + 256 * j + 4 * lane);
    return o; }
__device__ __forceinline__ RowVec ld_row_bf16(const bf16_t* r, int lane) { RowVec o;
#pragma unroll
    for (int j = 0; j < 4; ++j) { const u32x2 w = *(const u32x2*)(r + 256 * j + 4 * lane); o.v[j] = (f32x4){bf2f(w.x & 0xffffu), bf2f(w.x >> 16), bf2f(w.y & 0xffffu), bf2f(w.y >> 16)}; }
    return o; }
__device__ __forceinline__ void st_row_f32(float* r, int lane, const RowVec& o) {
#pragma unroll
    for (int j = 0; j < 4; ++j) *(f32x4*)(r + 256 * j + 4 * lane) = o.v[j]; }
__device__ __forceinline__ void st_row_bf16(bf16_t* r, int lane, const RowVec& o) {
#pragma unroll
    for (int j = 0; j < 4; ++j) st_bf4(r + 256 * j + 4 * lane, o.v[j]); }
__device__ __forceinline__ float row_rs(const RowVec& x) { float s = 0.f;
#pragma unroll
    for (int j = 0; j < 4; ++j) s += (x.v[j].x * x.v[j].x + x.v[j].y * x.v[j].y) + (x.v[j].z * x.v[j].z + x.v[j].w * x.v[j].w);
    return rsqrtf(wave_sum(s) * (1.f / D) + EPS); }
__device__ __forceinline__ void ld_modvec(const P& p, const float* g, int l, int cond, int sub, int lane, RowVec& a, RowVec& s) {
    const RowVec gv = ld_row_f32(g, lane), sc = ld_row_f32(modp(p, l, cond, sub * 3 + 1), lane); s = ld_row_f32(modp(p, l, cond, sub * 3), lane);
#pragma unroll
    for (int j = 0; j < 4; ++j) a.v[j] = gv.v[j] * (sc.v[j] + 1.f); }
__device__ __forceinline__ void seg_range(int s, int& r0, int& n, int& cond) { if (s == 0) { r0 = 0; n = NCTX; cond = 2; } else { r0 = NCTX + (s - 1) * SEQ; n = SEQ; cond = s - 1; } }


__device__ __forceinline__ void ph_mod2_route(const P& p, int l, LAS unsigned char* lds) {
    const int tid = TIDX, lane = tid & 63, wave = __builtin_amdgcn_readfirstlane(tid >> 6), fr = lane & 15, fq = lane >> 4;
    LAS float* wl = (LAS float*)lds;
    LAS float* av = (LAS float*)(lds + 131072);
    LAS float* sv = av + 3 * D;
    LAS int* lcnt = (LAS int*)(lds + 155648);
    LAS int* rec = lcnt + 64;
    __syncthreads();
    { const f32x4* src = (const f32x4*)(p.router_w + (size_t)l * D * NE);
      const int rot = (blockIdx.x >> 3) + (blockIdx.x & 7) * 2;
      for (int i = 0; i < 16; ++i) { const int e = (((i + rot) & 15) << 9) + tid; const int k = e >> 3, e0 = (e & 7) * 4; const f32x4 w = src[e];
          const int t = k >> 6, kq = (k >> 4) & 3, c = k & 15, q = c >> 2, r = c & 3;
#pragma unroll
          for (int i = 0; i < 4; ++i) { const int ex = e0 + i; wl[((((t * 2 + (ex >> 4)) * 4 + q) * 64 + kq * 16 + (ex & 15)) << 2) + r] = w[i]; } } }
    for (int e = tid; e < 3 * D; e += 512) { const int cond = e >> 10, k = e & 1023; av[e] = p.norm2_g[l * D + k] * (1.f + modp(p, l, cond, 4)[k]); sv[e] = modp(p, l, cond, 3)[k]; }
    if (tid < 32) lcnt[tid] = 0;
    __syncthreads();
    const bool ctxwg = (l == 0 && blockIdx.x < NCTX / 16);
    const bool rowwave = wave < 4 || (wave == 4 && ctxwg);
    if (rowwave) {
        unsigned char* Hb8 = (unsigned char*)(p.ws + WS_HB8); const bf16_t* X1 = (const bf16_t*)(p.ws + WS_X1);
        const int row0 = (wave == 4) ? (int)blockIdx.x * 16 : NCTX + (int)blockIdx.x * 64 + wave * 16;
        const int cond = (wave == 4) ? 2 : (int)((blockIdx.x * 64 + wave * 16) >> 13);
        const int row = row0 + fr;
        const bf16_t* xr = X1 + (size_t)row * D + 16 * fq;
        float rs; u32x4 ring[4][2];
        { float ss = 0.f;
#pragma unroll
          for (int t = 0; t < 16; ++t) { const u32x4 r0 = *(const u32x4*)(xr + 64 * t), r1 = *(const u32x4*)(xr + 64 * t + 8);
              if (t < 4) { ring[t][0] = r0; ring[t][1] = r1; }
#pragma unroll
              for (int j = 0; j < 4; ++j) { const float a0 = bf2f(r0[j] & 0xffffu), a1 = __uint_as_float(r0[j] & 0xffff0000u), b0 = bf2f(r1[j] & 0xffffu), b1 = __uint_as_float(r1[j] & 0xffff0000u);
                  ss += (a0 * a0 + a1 * a1) + (b0 * b0 + b1 * b1); } }
          ss += __shfl_xor(ss, 16); ss += __shfl_xor(ss, 32);
          rs = rsqrtf(ss * (1.f / D) + EPS); }
        f32x4 acc0 = {0.f, 0.f, 0.f, 0.f}, acc1 = {0.f, 0.f, 0.f, 0.f};
        { const LAS float* ap = av + cond * D + 16 * fq; const LAS float* sp = sv + cond * D + 16 * fq; unsigned char* hp = Hb8 + (size_t)row * D + 16 * fq;
          const LAS float* wp = wl + (lane << 2);
#pragma unroll 1
          for (int t0 = 0; t0 < 16; t0 += 4) {
#pragma unroll
          for (int ts = 0; ts < 4; ++ts) { const int t = t0 + ts; const u32x4 r0 = ring[ts][0], r1 = ring[ts][1];
              if (t0 < 12) { ring[ts][0] = *(const u32x4*)(xr + 64 * (t + 4)); ring[ts][1] = *(const u32x4*)(xr + 64 * (t + 4) + 8); }
              f32x4 h[4];
              const unsigned xw[8] = {r0[0], r0[1], r0[2], r0[3], r1[0], r1[1], r1[2], r1[3]};
#pragma unroll
              for (int q = 0; q < 4; ++q) { const f32x4 a4 = *(const LAS f32x4*)(ap + 64 * t + 4 * q), s4 = *(const LAS f32x4*)(sp + 64 * t + 4 * q);
                  const unsigned w0 = xw[2 * q], w1 = xw[2 * q + 1];
                  const f32x4 x4 = {bf2f(w0 & 0xffffu), __uint_as_float(w0 & 0xffff0000u), bf2f(w1 & 0xffffu), __uint_as_float(w1 & 0xffff0000u)};
                  h[q] = x4 * rs * a4 + s4; }
              *(u32x4*)(hp + 64 * t) = (u32x4){pk4_fp8(h[0][0], h[0][1], h[0][2], h[0][3]), pk4_fp8(h[1][0], h[1][1], h[1][2], h[1][3]), pk4_fp8(h[2][0], h[2][1], h[2][2], h[2][3]), pk4_fp8(h[3][0], h[3][1], h[3][2], h[3][3])};
#pragma unroll
              for (int q = 0; q < 4; ++q) { const f32x4 wa = *(const LAS f32x4*)(wp + ((t * 2 + 0) * 4 + q) * 256), wb = *(const LAS f32x4*)(wp + ((t * 2 + 1) * 4 + q) * 256);
#pragma unroll
                  for (int r = 0; r < 4; ++r) { acc0 = __builtin_amdgcn_mfma_f32_16x16x4f32(wa[r], h[q][r], acc0, 0, 0, 0); acc1 = __builtin_amdgcn_mfma_f32_16x16x4f32(wb[r], h[q][r], acc1, 0, 0, 0); } }
          } } }
        {
          const f32x4 b0 = *(const f32x4*)(p.router_b + l * NE + 4 * fq), b1 = *(const f32x4*)(p.router_b + l * NE + 16 + 4 * fq);
          float v[8];
#pragma unroll
          for (int r = 0; r < 4; ++r) { v[r] = acc0[r] + b0[r]; v[4 + r] = acc1[r] + b1[r]; }
          float tv[4]; int te[4];
#pragma unroll
          for (int k = 0; k < 4; ++k) { float bv = v[0]; int bc = 0;
#pragma unroll
              for (int ci = 1; ci < 8; ++ci) if (v[ci] > bv) { bv = v[ci]; bc = ci; }
              int bi = ((bc >> 2) << 4) + 4 * fq + (bc & 3);
#pragma unroll
              for (int o = 16; o < 64; o <<= 1) { const float ov = __shfl_xor(bv, o); const int oi = __shfl_xor(bi, o); if (ov > bv || (ov == bv && oi < bi)) { bv = ov; bi = oi; } }
              tv[k] = bv; te[k] = bi;
#pragma unroll
              for (int ci = 0; ci < 8; ++ci) if (((ci >> 2) << 4) + 4 * fq + (ci & 3) == bi) v[ci] = -3.0e38f; }
          const float e1 = __expf(tv[1] - tv[0]), e2 = __expf(tv[2] - tv[0]), e3 = __expf(tv[3] - tv[0]); const float inv = 1.f / (1.f + e1 + e2 + e3);
          { const int ek = fq == 0 ? te[0] : fq == 1 ? te[1] : fq == 2 ? te[2] : te[3];
            const float gk = (fq == 0 ? 1.f : fq == 1 ? e1 : fq == 2 ? e2 : e3) * inv;
            const int lp = __hip_atomic_fetch_add(lcnt + ek, 1, __ATOMIC_RELAXED, __HIP_MEMORY_SCOPE_WORKGROUP);
            LAS int* rc = rec + ((wave * 16 + fr) * 4 + fq) * 4; rc[0] = row; rc[1] = ek; rc[2] = lp; rc[3] = __float_as_int(gk); } }
    } else {
        const int nb = ctxwg ? 3 : 4, bi = wave - (ctxwg ? 5 : 4);
        constexpr int RS0 = 7, RNI = (12 - RS0) * 8;
        CvtRegs ca, cb;
        auto item = [&](int j) { return bg_item(l, (RS0 + (j >> 3)) * 2048 + (int)blockIdx.x * 8 + (j & 7)); };
        int j = bi; if (j < RNI) cvt_item_issue(ca, p, item(j), lane);
#pragma unroll 1
        for (; j < RNI; j += 2 * nb) { const bool two = j + nb < RNI; if (two) cvt_item_issue(cb, p, item(j + nb), lane);
            cvt_item_finish(ca, p, item(j), lane);
            if (j + 2 * nb < RNI) cvt_item_issue(ca, p, item(j + 2 * nb), lane);
            if (two) cvt_item_finish(cb, p, item(j + nb), lane); }
    }
    __syncthreads();
    int* cnt = (int*)(p.ws + CTL_CNT) + l * NE * CNT_STRIDE; int* list = (int*)(p.ws + WS_ROUTE + RT_LIST);
    int* asg_e = (int*)(p.ws + WS_ROUTE + RT_ASGE); int* asg_p = (int*)(p.ws + WS_ROUTE + RT_ASGP); float* gate = (float*)(p.ws + WS_ROUTE + RT_GATE);
    const int tokbase = (l == 0) ? 0 : NCTX;
    const int tid2 = TIDX, lane2 = tid2 & 63, wave2 = tid2 >> 6;
    if (tid2 < 32) { const int c = lcnt[tid2]; lcnt[tid2] = c ? atomicAdd(cnt + tid2 * CNT_STRIDE, c) : 0; }
    __syncthreads();
    if (wave2 < 4 || (wave2 == 4 && l == 0 && blockIdx.x < NCTX / 16)) {
        const LAS int* rc = rec + (wave2 * 64 + lane2) * 4; const int row = rc[0], ek = rc[1], pos = lcnt[ek] + rc[2]; const int tokm = row - tokbase, k = lane2 & 3;
        list[(size_t)ek * NTOK + pos] = row; asg_e[tokm * 4 + k] = ek; asg_p[tokm * 4 + k] = pos; gate[tokm * 4 + k] = __int_as_float(rc[3]); }
}

__device__ __forceinline__ void ph_combine(const P& p, int l) {
    const int tid = TIDX, lane = tid & 63, gw = blockIdx.x * 8 + (tid >> 6), NGW = gridDim.x * 8;
    const int* cnt = (const int*)(p.ws + CTL_CNT) + l * NE * CNT_STRIDE;
    int ps; { const int c = cnt[(lane & 31) * CNT_STRIDE]; const int pc = (c + 255) & ~255; int incl = pc;
#pragma unroll
        for (int o = 1; o < 32; o <<= 1) { const int t = __shfl_up(incl, o); if ((lane & 31) >= o) incl += t; }
        ps = incl - pc; }
    typedef int i32x4v __attribute__((ext_vector_type(4)));
    const i32x4v* asg_e = (const i32x4v*)(p.ws + WS_ROUTE + RT_ASGE); const i32x4v* asg_p = (const i32x4v*)(p.ws + WS_ROUTE + RT_ASGP); const f32x4* gate = (const f32x4*)(p.ws + WS_ROUTE + RT_GATE);
    const bf16_t* Yb = (const bf16_t*)(p.ws + WS_YB); const bf16_t* X1 = (const bf16_t*)(p.ws + WS_X1); bf16_t* X2 = (bf16_t*)(p.ws + WS_X2); bf16_t* Hb = (bf16_t*)(p.ws + WS_HB);
    const int tokbase = (l == 0) ? 0 : NCTX;
    for (int s = (l == 0 ? 0 : 1); s < 3; ++s) { int r0, n, cond; seg_range(s, r0, n, cond);
        const RowVec g2 = ld_row_f32(modp(p, l, cond, 5), lane); RowVec a, sh;
        if (l == 0) ld_modvec(p, p.norm1_g + D, 1, cond, 0, lane, a, sh); else { a = ld_row_f32(p.final_g, lane); sh = a; }
        i32x4v eA = {0, 0, 0, 0}, pA = eA; f32x4 gA = {0.f, 0.f, 0.f, 0.f}; RowVec xA; f32x4 gB = gA; RowVec xB; u32x2 yB[4][4];
#define CMB_LOAD_A(rr) do { const int tokm_ = r0 + (rr) - tokbase; eA = asg_e[tokm_]; pA = asg_p[tokm_]; gA = gate[tokm_]; xA = ld_row_bf16(X1 + (size_t)(r0 + (rr)) * D, lane); } while (0)
#define CMB_LOAD_B() do { _Pragma("unroll") for (int k = 0; k < 4; ++k) { const int prow_ = __shfl(ps, eA[k]) + pA[k]; const bf16_t* yr_ = Yb + (size_t)prow_ * D; \
            _Pragma("unroll") for (int j = 0; j < 4; ++j) yB[k][j] = *(const u32x2*)(yr_ + 256 * j + 4 * lane); } gB = gA; xB = xA; } while (0)
        if (gw < n) { CMB_LOAD_A(gw); CMB_LOAD_B(); if (gw + NGW < n) CMB_LOAD_A(gw + NGW); }
        for (int r = gw; r < n; r += NGW) { const int row = r0 + r;
            RowVec y;
#pragma unroll
            for (int j = 0; j < 4; ++j) y.v[j] = (f32x4){0.f, 0.f, 0.f, 0.f};
#pragma unroll
            for (int k = 0; k < 4; ++k) { const float gk = gB[k];
#pragma unroll
                for (int j = 0; j < 4; ++j) { const u32x2 w = yB[k][j];
                    y.v[j].x += gk * bf2f(w.x & 0xffffu); y.v[j].y += gk * bf2f(w.x >> 16); y.v[j].z += gk * bf2f(w.y & 0xffffu); y.v[j].w += gk * bf2f(w.y >> 16); } }
            RowVec x = xB;
            if (r + NGW < n) { CMB_LOAD_B(); if (r + 2 * NGW < n) CMB_LOAD_A(r + 2 * NGW); }
#pragma unroll
            for (int j = 0; j < 4; ++j) x.v[j] = x.v[j] + g2.v[j] * y.v[j];
            const float rs = row_rs(x);
            if (l == 0) { st_row_bf16(X2 + (size_t)row * D, lane, x);
#pragma unroll
                for (int j = 0; j < 4; ++j) x.v[j] = x.v[j] * rs * a.v[j] + sh.v[j];
                if (row < NCTX) st_row_bf16(Hb + (size_t)row * D, lane, x);
                else {
#pragma unroll
                    for (int j = 0; j < 4; ++j) *(unsigned*)((unsigned char*)(p.ws + WS_HBH8) + (size_t)row * D + 256 * j + 4 * lane) = pk4_fp8(x.v[j].x, x.v[j].y, x.v[j].z, x.v[j].w); } }
            else {
#pragma unroll
                for (int j = 0; j < 4; ++j) x.v[j] = x.v[j] * rs * a.v[j];
                st_row_f32(p.out + (size_t)(row - NCTX) * D, lane, x); }
        }
#undef CMB_LOAD_A
#undef CMB_LOAD_B
    }
}

namespace pg8 {
constexpr int BM = 256, BK = 64, HALF = 128, HTB = HALF * BK * 2, STAGE_BYTES = 8 * HTB;
__device__ __forceinline__ int lds_byte(int r, int c) { const int st = (r >> 4) * 2 + (c >> 5), rr = r & 15, cc = c & 31, ob = rr * 64 + cc * 2; return st * 1024 + (ob ^ (((ob >> 9) & 1) << 5)); }
__device__ __forceinline__ void stage_rc(int b, int& R, int& C) { const int st = b / 1024, sb = b % 1024, swz = sb ^ (((sb >> 9) & 1) << 5); R = (st >> 1) * 16 + swz / 64; C = (st & 1) * 32 + (swz % 64) / 2; }
__device__ __forceinline__ int perm32(int rho) { const int n = rho >> 4, i = rho & 15; return 8 * (i >> 2) + 4 * n + (i & 3); }
struct GUnit { const char* a; const char* b0; const char* b1; int e0, e1, e2, e3; };
__device__ __forceinline__ unsigned cvt_pk_bf16(float lo, float hi) { unsigned r; asm volatile("v_cvt_pk_bf16_f32 %0, %1, %2" : "=v"(r) : "v"(lo), "v"(hi)); return r; }

typedef int i32x4 __attribute__((ext_vector_type(4)));
typedef int i32x8 __attribute__((ext_vector_type(8)));
__device__ __forceinline__ i32x8 cat8(bf16x8 lo, bf16x8 hi) { return __builtin_shufflevector(__builtin_bit_cast(i32x4, lo), __builtin_bit_cast(i32x4, hi), 0, 1, 2, 3, 4, 5, 6, 7); }
template <class Epi, class Sched, bool FP8 = false, bool ALIGN_EPI = true, bool SP2 = true>
__device__ __forceinline__ void gemm_phase(LAS unsigned char* lds, const int RB, const Sched& S, const Epi& E) {
    const int tid = TIDX, wid = __builtin_amdgcn_readfirstlane(tid >> 6), lane = tid & 63, wr = wid >> 2, wc = wid & 3, fr = lane & 15, fq = lane >> 4;
    const int nt = RB / 128;
    int Rr[2], Cc[2]; unsigned voffB[2];
#pragma unroll
    for (int i = 0; i < 2; ++i) { stage_rc(tid * 16 + i * 8192, Rr[i], Cc[i]); const int Rb = Epi::PERM ? ((Rr[i] & ~31) + perm32(Rr[i] & 31)) : Rr[i]; voffB[i] = (unsigned)(Rb * RB + Cc[i] * 2); }
    const size_t kstep = (size_t)(BK * 2);
    const unsigned ldsw = (unsigned)wid * 1024u;
    const int aoff = lds_byte(wr * 64 + fr, fq * 8), boff = lds_byte(wc * 32 + fr, fq * 8);
#define PG8_SA(b, h) (((b) * 2 + (h)) * HTB)
#define PG8_SB(b, h) ((4 + (b) * 2 + (h)) * HTB)
#define PG8_STAGE(bufoff, gbase, voff) do { _Pragma("unroll") for (int _i = 0; _i < 2; ++_i) \
        __builtin_amdgcn_global_load_lds((const unsigned*)((const char*)(gbase) + (voff)[_i]), (LAS unsigned*)(lds + (bufoff) + ldsw + _i * 8192), 16, 0, 0); } while (0)
#define PG8_LDA(dst, b, h) do { _Pragma("unroll") for (int m = 0; m < 4; ++m) { const bf16x8 _l = *(const LAS bf16x8*)(lds + PG8_SA(b, h) + aoff + m * 2048), _h = *(const LAS bf16x8*)(lds + PG8_SA(b, h) + aoff + m * 2048 + 1024); \
        if constexpr (FP8) dst##8[m] = cat8(_l, _h); else { dst[m][0] = _l; dst[m][1] = _h; } } } while (0)
#define PG8_LDB(dst, b, h) do { _Pragma("unroll") for (int n = 0; n < 2; ++n) { const bf16x8 _l = *(const LAS bf16x8*)(lds + PG8_SB(b, h) + boff + n * 2048), _h = *(const LAS bf16x8*)(lds + PG8_SB(b, h) + boff + n * 2048 + 1024); \
        if constexpr (FP8) dst##8[n] = cat8(_l, _h); else { dst[n][0] = _l; dst[n][1] = _h; } } } while (0)
#define PG8_MMA(ai, bj, At, Bt) do { __builtin_amdgcn_s_setprio(1); \
        if constexpr (FP8) { _Pragma("unroll") for (int m = 0; m < 4; ++m) _Pragma("unroll") for (int n = 0; n < 2; ++n) \
            asm volatile("v_mfma_scale_f32_16x16x128_f8f6f4 %0, %1, %2, %0, %3, %3 op_sel_hi:[0,0,0]" : "+v"(acc[ai][bj][m][n]) : "v"(Bt##8[n]), "v"(At##8[m]), "v"(mx_one)); } \
        else { _Pragma("unroll") for (int m = 0; m < 4; ++m) _Pragma("unroll") for (int n = 0; n < 2; ++n) _Pragma("unroll") for (int k = 0; k < 2; ++k) \
            acc[ai][bj][m][n] = __builtin_amdgcn_mfma_f32_16x16x32_bf16(Bt[n][k], At[m][k], acc[ai][bj][m][n], 0, 0, 0); } \
        __builtin_amdgcn_s_setprio(0); } while (0)
#define PG8_WAIT_V(n) asm volatile("s_waitcnt vmcnt(" #n ")" ::: "memory")
#define PG8_WAIT_L(n) asm volatile("s_waitcnt lgkmcnt(" #n ")" ::: "memory")
#define PG8_BAR __builtin_amdgcn_s_barrier()
#define PG8_SCHED __builtin_amdgcn_sched_barrier(0)
    const unsigned mx_one = 0x7f7f7f7fu;
    GUnit cur, nxt; int ui = 0;
    if (!S.next(0, cur)) return;
    f32x4 acc[2][2][4][2];
#pragma unroll
    for (int a = 0; a < 2; ++a)
#pragma unroll
        for (int b = 0; b < 2; ++b)
#pragma unroll
            for (int m = 0; m < 4; ++m)
#pragma unroll
                for (int n = 0; n < 2; ++n) acc[a][b][m][n] = (f32x4){0.f, 0.f, 0.f, 0.f};
    bf16x8 At[4][2], B0[2][2], B1[2][2]; i32x8 At8[4], B08[2], B18[2];
    unsigned cA0[2], cA1[2];
#pragma unroll
    for (int i = 0; i < 2; ++i) { cA0[i] = S.a_off(0, cur, Rr[i]) + (unsigned)Cc[i] * 2u; cA1[i] = S.a_off(0, cur, HALF + Rr[i]) + (unsigned)Cc[i] * 2u; }
    const char* cA = cur.a; const char* cB0 = cur.b0; const char* cB1 = cur.b1;
    if constexpr (SP2) {
        PG8_STAGE(PG8_SB(0, 0), cB0, voffB); PG8_STAGE(PG8_SB(0, 1), cB1, voffB); PG8_STAGE(PG8_SA(0, 0), cA, cA0); PG8_STAGE(PG8_SA(0, 1), cA, cA1);
        if (wr == 1) PG8_BAR;
        PG8_WAIT_V(2); PG8_BAR;
        PG8_STAGE(PG8_SB(1, 0), cB0 + kstep, voffB); PG8_STAGE(PG8_SA(1, 0), cA + kstep, cA0); PG8_STAGE(PG8_SB(1, 1), cB1 + kstep, voffB);
        PG8_WAIT_V(6); PG8_BAR;
    } else {
        PG8_STAGE(PG8_SB(0, 0), cB0, voffB); PG8_STAGE(PG8_SA(0, 0), cA, cA0); PG8_STAGE(PG8_SB(0, 1), cB1, voffB); PG8_STAGE(PG8_SA(0, 1), cA, cA1);
        if (wr == 1) PG8_BAR;
        PG8_WAIT_V(4); PG8_BAR;
        PG8_STAGE(PG8_SB(1, 0), cB0 + kstep, voffB); PG8_STAGE(PG8_SA(1, 0), cA + kstep, cA0); PG8_STAGE(PG8_SB(1, 1), cB1 + kstep, voffB);
        PG8_WAIT_V(6); PG8_BAR;
    }
    for (;;) {
        const bool has_next = S.next(ui + 1, nxt);
        const char* nA = has_next ? nxt.a : cA; const char* nB0 = has_next ? nxt.b0 : cB0; const char* nB1 = has_next ? nxt.b1 : cB1;
#pragma unroll 1
        for (int t = 0; t < nt; t += 2) {
            const bool last = (t == nt - 2);
            const char* a1 = cA + (size_t)(t + 1) * kstep;
            const char* a2 = last ? nA : cA + (size_t)(t + 2) * kstep; const char* b20 = last ? nB0 : cB0 + (size_t)(t + 2) * kstep; const char* b21 = last ? nB1 : cB1 + (size_t)(t + 2) * kstep;
            const char* a3 = a2 + kstep; const char* b30 = b20 + kstep; const char* b31 = b21 + kstep;
            unsigned xA0[2], xA1[2];
#pragma unroll
            for (int i = 0; i < 2; ++i) { xA0[i] = cA0[i]; xA1[i] = cA1[i]; }
            if (last && has_next) { int tz = threadIdx.x; asm volatile("" : "+v"(tz));
#pragma unroll
                for (int i = 0; i < 2; ++i) { int R_, C_; stage_rc(tz * 16 + i * 8192, R_, C_); xA0[i] = S.a_off(ui + 1, nxt, R_) + (unsigned)C_ * 2u; xA1[i] = S.a_off(ui + 1, nxt, HALF + R_) + (unsigned)C_ * 2u; } }
            if constexpr (SP2) {
            const bool relax = (t == 0) && (ui > 0) && (Epi::VM_OPS > 0);
            PG8_LDB(B0, 0, 0); PG8_LDB(B1, 0, 1); PG8_SCHED; PG8_LDA(At, 0, 0); PG8_STAGE(PG8_SA(1, 1), a1, cA1);
            if (relax) { if constexpr (Epi::VM_OPS == 4) PG8_WAIT_V(12); else if constexpr (Epi::VM_OPS == 8) PG8_WAIT_V(16); else if constexpr (Epi::VM_OPS == 16) PG8_WAIT_V(24); else if constexpr (Epi::VM_OPS == 32) PG8_WAIT_V(40); else PG8_WAIT_V(8); } else PG8_WAIT_V(8);
            PG8_WAIT_L(0); PG8_BAR; PG8_MMA(0, 0, At, B0); PG8_MMA(0, 1, At, B1); PG8_BAR; PG8_SCHED;
            PG8_LDA(At, 0, 1); PG8_STAGE(PG8_SB(0, 0), b20, voffB); PG8_STAGE(PG8_SB(0, 1), b21, voffB); PG8_STAGE(PG8_SA(0, 0), a2, xA0);
            if (relax) { if constexpr (Epi::VM_OPS == 4) PG8_WAIT_V(12); else if constexpr (Epi::VM_OPS == 8) PG8_WAIT_V(16); else if constexpr (Epi::VM_OPS == 16) PG8_WAIT_V(24); else if constexpr (Epi::VM_OPS == 32) PG8_WAIT_V(40); else PG8_WAIT_V(8); } else PG8_WAIT_V(8);
            PG8_WAIT_L(0); PG8_BAR; PG8_MMA(1, 0, At, B0); PG8_MMA(1, 1, At, B1); PG8_BAR; PG8_SCHED;
            PG8_LDB(B0, 1, 0); PG8_LDB(B1, 1, 1); PG8_SCHED; PG8_LDA(At, 1, 0); PG8_STAGE(PG8_SA(0, 1), a2, xA1);
            PG8_WAIT_V(8); PG8_WAIT_L(0); PG8_BAR; PG8_MMA(0, 0, At, B0); PG8_MMA(0, 1, At, B1); PG8_BAR; PG8_SCHED;
            PG8_LDA(At, 1, 1); PG8_STAGE(PG8_SB(1, 0), b30, voffB); PG8_STAGE(PG8_SB(1, 1), b31, voffB); PG8_STAGE(PG8_SA(1, 0), a3, xA0);
            PG8_WAIT_V(8); PG8_WAIT_L(0); PG8_BAR; PG8_MMA(1, 0, At, B0); PG8_MMA(1, 1, At, B1); PG8_BAR; PG8_SCHED;
            } else {
            PG8_LDB(B0, 0, 0); PG8_SCHED; PG8_LDA(At, 0, 0); PG8_STAGE(PG8_SA(1, 1), a1, cA1);
            PG8_WAIT_L(8); PG8_BAR; PG8_WAIT_L(0); PG8_MMA(0, 0, At, B0); PG8_BAR; PG8_SCHED;
            PG8_LDB(B1, 0, 1); PG8_STAGE(PG8_SB(0, 0), b20, voffB);
            PG8_BAR; PG8_WAIT_L(0); PG8_MMA(0, 1, At, B1); PG8_BAR;
            PG8_LDA(At, 0, 1); PG8_STAGE(PG8_SA(0, 0), a2, xA0);
            PG8_BAR; PG8_WAIT_L(0); PG8_MMA(1, 0, At, B0); PG8_BAR; PG8_SCHED;
            PG8_STAGE(PG8_SB(0, 1), b21, voffB);
            PG8_WAIT_V(6); PG8_BAR; PG8_MMA(1, 1, At, B1); PG8_BAR;
            PG8_LDB(B0, 1, 0); PG8_SCHED; PG8_LDA(At, 1, 0); PG8_STAGE(PG8_SA(0, 1), a2, xA1);
            PG8_WAIT_L(8); PG8_BAR; PG8_WAIT_L(0); PG8_MMA(0, 0, At, B0); PG8_BAR; PG8_SCHED;
            PG8_LDB(B1, 1, 1); PG8_STAGE(PG8_SB(1, 0), b30, voffB);
            PG8_BAR; PG8_WAIT_L(0); PG8_MMA(0, 1, At, B1); PG8_BAR;
            PG8_LDA(At, 1, 1); PG8_STAGE(PG8_SA(1, 0), a3, xA0);
            PG8_BAR; PG8_WAIT_L(0); PG8_MMA(1, 0, At, B0); PG8_BAR; PG8_SCHED;
            PG8_STAGE(PG8_SB(1, 1), b31, voffB);
            PG8_WAIT_V(6); PG8_BAR; PG8_MMA(1, 1, At, B1); PG8_BAR;
            }
        }
        if constexpr (ALIGN_EPI) { if (wr == 0) PG8_BAR; }
        if constexpr (FP8) asm volatile("s_nop 15\n\ts_nop 15" ::: "memory");
        { int tz = threadIdx.x; asm volatile("" : "+v"(tz)); const int wid_ = tz >> 6, lane_ = tz & 63; E(acc, cur, wid_ >> 2, wid_ & 3, lane_ & 15, lane_ >> 4); }
        if (!has_next) break;
#pragma unroll
        for (int a = 0; a < 2; ++a)
#pragma unroll
            for (int b = 0; b < 2; ++b)
#pragma unroll
                for (int m = 0; m < 4; ++m)
#pragma unroll
                    for (int n = 0; n < 2; ++n) acc[a][b][m][n] = (f32x4){0.f, 0.f, 0.f, 0.f};
        cur = nxt; cA = nA; cB0 = nB0; cB1 = nB1; ++ui;
        { int tz = threadIdx.x; asm volatile("" : "+v"(tz));
#pragma unroll
          for (int i = 0; i < 2; ++i) { int R_, C_; stage_rc(tz * 16 + i * 8192, R_, C_); cA0[i] = S.a_off(ui, cur, R_) + (unsigned)C_ * 2u; cA1[i] = S.a_off(ui, cur, HALF + R_) + (unsigned)C_ * 2u; } }
        if constexpr (ALIGN_EPI) { if (wr == 1) PG8_BAR; }
    }
    PG8_WAIT_V(0);
    if constexpr (!ALIGN_EPI) { if (wr == 0) PG8_BAR; }
    PG8_BAR;
#undef PG8_SA
#undef PG8_SB
#undef PG8_STAGE
#undef PG8_LDA
#undef PG8_LDB
#undef PG8_MMA
#undef PG8_WAIT_V
#undef PG8_WAIT_L
#undef PG8_BAR
#undef PG8_SCHED
}
}

__device__ __forceinline__ void moe_tables(const P& p, int l, LAS int* tb) {
    __syncthreads();
    if (TIDX < 64) { const int lane = TIDX; const int c = ((const int*)(p.ws + CTL_CNT))[(l * NE + (lane & 31)) * CNT_STRIDE]; const int pc = (c + 255) & ~255; int incl = pc;
#pragma unroll
        for (int o = 1; o < 32; o <<= 1) { const int t = __shfl_up(incl, o); if ((lane & 31) >= o) incl += t; }
        if (lane < 32) { tb[lane] = incl - pc; tb[64 + lane] = (incl - pc) >> 8; tb[128 + lane] = c; if (lane == 31) { tb[32] = incl; tb[96] = incl >> 8; } } }
    __syncthreads();
}


typedef int ud4 __attribute__((ext_vector_type(4)));
constexpr int LDS_TB = pg8::STAGE_BYTES, LDS_GT = LDS_TB + 1024, LDS_UT = LDS_GT + 12288, LDS_BT = LDS_UT + 256;
static_assert(LDS_BT + 12288 <= LDS_MISC, "LDS map");
__device__ __forceinline__ int moe_find_e(const LAS int* tb, int rbi) { int e = 0;
#pragma unroll 1
    for (int i = 1; i < 32; ++i) if (tb[64 + i] <= rbi) e = i;
    return e; }
__device__ __forceinline__ f32x4 swiglu4(f32x4 g, f32x4 l) { f32x4 o;
#pragma unroll
    for (int j = 0; j < 4; ++j) { const float gl = __builtin_fminf(g[j], 7.f), li = __builtin_amdgcn_fmed3f(l[j], -7.f, 7.f);
        const float sg = __builtin_amdgcn_rcpf(1.f + __builtin_amdgcn_exp2f(gl * (-1.702f * 1.4426950408889634f))); o[j] = (gl * sg) * __builtin_fmaf(li, ACT_SCALE, ACT_SCALE); }
    return o; }

template <int SH> __device__ __forceinline__ void moe_unit_table(LAS int* tb, LAS int* ut, int nunits) {
    const int i = TIDX; if (i < 12) { const int L = i * (int)gridDim.x + (int)blockIdx.x; ud4 d = {0, 0, 0, 0};
        if (L < nunits) { const int rbi = L >> SH, pn = L & ((1 << SH) - 1), e = moe_find_e(tb, rbi); d.x = tb[e] + (rbi - tb[64 + e]) * 256; d.y = pn; d.z = e; d.w = rbi - tb[64 + e]; }
        ((LAS ud4*)ut)[i] = d; }
    __syncthreads();
}
struct SchedMoe1 { const LAS int* ut; const LAS unsigned* gt; const char* Hb; const char* W1; int nunits, G, bid;
    __device__ __forceinline__ bool next(int i, pg8::GUnit& u) const { if (i * G + bid >= nunits) return false; const ud4 d = ((const LAS ud4*)ut)[i];
        u.a = Hb; u.b0 = W1 + (size_t)(d.z * 2 * DFF + d.y * 128) * D; u.b1 = u.b0 + (size_t)DFF * D;
        u.e0 = d.x; u.e1 = d.y * 128; u.e2 = d.z; u.e3 = i; return true; }
    __device__ __forceinline__ unsigned a_off(int i, const pg8::GUnit&, int R) const { return gt[i * 256 + R]; } };
struct EpiSwigluP { static constexpr bool PERM = true; static constexpr int VM_OPS = 4; unsigned char* Act; const LAS float* bt;
    __device__ __forceinline__ void operator()(const f32x4 (&acc)[2][2][4][2], const pg8::GUnit& u, int wr, int wc, int fr, int fq) const {
        const LAS float* bias = bt + u.e3 * 256 + wc * 32 + 8 * fq; const int odd = fq & 1; const int colb = u.e1 + wc * 32 + 8 * (fq - odd); const float ws = 1.f / W_SCALE;
        const f32x4 bg0 = *(const LAS f32x4*)(bias), bg1 = *(const LAS f32x4*)(bias + 4), bl0 = *(const LAS f32x4*)(bias + 128), bl1 = *(const LAS f32x4*)(bias + 132);
#pragma unroll
        for (int ai = 0; ai < 2; ++ai)
#pragma unroll
            for (int mp = 0; mp < 2; ++mp) { unsigned xy[2][2];
#pragma unroll
                for (int o = 0; o < 2; ++o) { const int m = 2 * mp + o;
                    const f32x4 v0 = swiglu4(acc[ai][0][m][0] * ws + bg0, acc[ai][1][m][0] * ws + bl0), v1 = swiglu4(acc[ai][0][m][1] * ws + bg1, acc[ai][1][m][1] * ws + bl1);
                    xy[o][0] = pk4_fp8(v0[0], v0[1], v0[2], v0[3]); xy[o][1] = pk4_fp8(v1[0], v1[1], v1[2], v1[3]); }
                const auto s0 = __builtin_amdgcn_permlane16_swap(xy[0][0], xy[1][0], false, false), s1 = __builtin_amdgcn_permlane16_swap(xy[0][1], xy[1][1], false, false);
                const size_t row = (size_t)(u.e0 + ai * 128 + wr * 64 + (2 * mp + odd) * 16 + fr);
                *(u32x4*)(Act + row * DFF + colb) = (u32x4){s0[0], s1[0], s0[1], s1[1]}; }
    } };
__device__ __forceinline__ void ph_moe1(const P& p, int l, LAS unsigned char* lds) {
    LAS int* tb = (LAS int*)(lds + LDS_TB); moe_tables(p, l, tb);
    LAS unsigned* gt = (LAS unsigned*)(lds + LDS_GT); LAS int* ut = (LAS int*)(lds + LDS_UT); LAS float* bt = (LAS float*)(lds + LDS_BT);
    const int nblk = tb[96], nunits = nblk * 8, G = gridDim.x, bid = blockIdx.x;
    moe_unit_table<3>(tb, ut, nunits);
    const int* list = (const int*)(p.ws + WS_ROUTE + RT_LIST); const int dummy = (l == 0) ? 0 : NCTX; const float* b1l = p.e_b1 + (size_t)l * NE * 2 * DFF;
    for (int q = TIDX; q < 12 * 256; q += 512) { const int i = q >> 8, R = q & 255; if (i * G + bid >= nunits) break; const ud4 d = ((const LAS ud4*)ut)[i];
        const int idx = d.w * 256 + R; const int row = idx < tb[128 + d.z] ? list[(size_t)d.z * NTOK + idx] : dummy;
        gt[q] = (unsigned)row * (unsigned)D;
        bt[q] = b1l[(size_t)d.z * 2 * DFF + (R < 128 ? d.y * 128 + R : DFF + d.y * 128 + (R - 128))]; }
    __syncthreads();
    SchedMoe1 S{ut, gt, (const char*)(p.ws + WS_HB8), (const char*)(p.ws + WS_W1T) + (size_t)l * NE * 2 * DFF * D, nunits, G, bid};
    EpiSwigluP E{(unsigned char*)(p.ws + WS_ACT), bt};
    pg8::gemm_phase<EpiSwigluP, SchedMoe1, true>(lds, D, S, E);
}
struct SchedMoe2 { const LAS int* ut; const char* Act; const char* W2; int nunits, G, bid;
    __device__ __forceinline__ bool next(int i, pg8::GUnit& u) const { if (i * G + bid >= nunits) return false; const ud4 d = ((const LAS ud4*)ut)[i];
        u.a = Act + (size_t)d.x * DFF; u.b0 = W2 + (size_t)(d.z * D + d.y * 256) * DFF; u.b1 = u.b0 + (size_t)128 * DFF;
        u.e0 = d.x; u.e1 = d.y * 256; u.e2 = d.z; u.e3 = i; return true; }
    __device__ __forceinline__ unsigned a_off(int, const pg8::GUnit&, int R) const { return (unsigned)R * (unsigned)DFF; } };
struct EpiBiasP { static constexpr bool PERM = true; static constexpr int VM_OPS = 16; bf16_t* Yb; const LAS float* bt;
    __device__ __forceinline__ void operator()(const f32x4 (&acc)[2][2][4][2], const pg8::GUnit& u, int wr, int wc, int fr, int fq) const {
#pragma unroll
        for (int bj = 0; bj < 2; ++bj) { const int cl = bj * 128 + wc * 32 + 8 * fq, col = u.e1 + cl; const f32x4 b0 = *(const LAS f32x4*)(bt + u.e3 * 256 + cl), b1 = *(const LAS f32x4*)(bt + u.e3 * 256 + cl + 4);
#pragma unroll
            for (int ai = 0; ai < 2; ++ai)
#pragma unroll
                for (int m = 0; m < 4; ++m) { const size_t row = (size_t)(u.e0 + ai * 128 + wr * 64 + m * 16 + fr); const f32x4 v0 = acc[ai][bj][m][0] * (1.f / (W_SCALE * ACT_SCALE)) + b0, v1 = acc[ai][bj][m][1] * (1.f / (W_SCALE * ACT_SCALE)) + b1;
                    u32x4 w; w.x = pg8::cvt_pk_bf16(v0[0], v0[1]); w.y = pg8::cvt_pk_bf16(v0[2], v0[3]); w.z = pg8::cvt_pk_bf16(v1[0], v1[1]); w.w = pg8::cvt_pk_bf16(v1[2], v1[3]);
                    *(u32x4*)(Yb + row * D + col) = w; } }
    } };
__device__ __forceinline__ void ph_moe2(const P& p, int l, LAS unsigned char* lds) {
    LAS int* tb = (LAS int*)(lds + LDS_TB); moe_tables(p, l, tb);
    LAS int* ut = (LAS int*)(lds + LDS_UT); LAS float* bt = (LAS float*)(lds + LDS_BT);
    const int nblk = tb[96], nunits = nblk * 4, G = gridDim.x, bid = blockIdx.x;
    moe_unit_table<2>(tb, ut, nunits);
    const float* b2l = p.e_b2 + (size_t)l * NE * D;
    for (int q = TIDX; q < 12 * 256; q += 512) { const int i = q >> 8, R = q & 255; if (i * G + bid >= nunits) break; const ud4 d = ((const LAS ud4*)ut)[i];
        bt[q] = b2l[(size_t)d.z * D + d.y * 256 + R]; }
    __syncthreads();
    SchedMoe2 S{ut, (const char*)(p.ws + WS_ACT), (const char*)(p.ws + WS_W2T) + (size_t)l * NE * D * DFF, nunits, G, bid};
    EpiBiasP E{(bf16_t*)(p.ws + WS_YB), bt};
    pg8::gemm_phase<EpiBiasP, SchedMoe2, true, false>(lds, DFF, S, E);
}

template <class AF, class BF, class EF>
__device__ __forceinline__ void kgemm_unit(LAS unsigned char* lds, const AF& af, const BF& bf, const EF& ef, int K) {
    const int tid = TIDX, lane = tid & 63, wid = tid >> 6, fr = lane & 15, fq = lane >> 4;
    const int ks = K >> 3, kb = wid * ks;
    f32x4 acc[4][4];
#pragma unroll
    for (int i = 0; i < 4; ++i)
#pragma unroll
        for (int j = 0; j < 4; ++j) acc[i][j] = (f32x4){0.f, 0.f, 0.f, 0.f};
    if (ks == 32) {
        bf16x8 a[4], b[4];
#pragma unroll
        for (int i = 0; i < 4; ++i) { a[i] = *(const bf16x8*)(af.row(i * 16 + fr) + kb + fq * 8); b[i] = *(const bf16x8*)(bf.row(i * 16 + fr) + kb + fq * 8); }
#pragma unroll
        for (int i = 0; i < 4; ++i)
#pragma unroll
            for (int j = 0; j < 4; ++j) acc[i][j] = __builtin_amdgcn_mfma_f32_16x16x32_bf16(b[j], a[i], acc[i][j], 0, 0, 0);
    } else {
        const bf16_t* ap[4]; const bf16_t* bp[4];
#pragma unroll
        for (int i = 0; i < 4; ++i) { ap[i] = af.row(i * 16 + fr) + kb + fq * 16; bp[i] = bf.row(i * 16 + fr) + kb + fq * 16; }
        bf16x8 a[2][4][2], b[2][4][2];
        const int npair = ks >> 6;
#pragma unroll
        for (int s = 0; s < 2; ++s) if (s < npair) {
#pragma unroll
            for (int i = 0; i < 4; ++i) { a[s][i][0] = *(const bf16x8*)(ap[i] + 64 * s); a[s][i][1] = *(const bf16x8*)(ap[i] + 64 * s + 8); b[s][i][0] = *(const bf16x8*)(bp[i] + 64 * s); b[s][i][1] = *(const bf16x8*)(bp[i] + 64 * s + 8); } }
        for (int s0 = 0; s0 < npair; s0 += 2) {
#pragma unroll
            for (int s = 0; s < 2; ++s) if (s0 + s < npair) {
#pragma unroll
                for (int h = 0; h < 2; ++h)
#pragma unroll
                    for (int i = 0; i < 4; ++i)
#pragma unroll
                        for (int j = 0; j < 4; ++j) acc[i][j] = __builtin_amdgcn_mfma_f32_16x16x32_bf16(b[s][j][h], a[s][i][h], acc[i][j], 0, 0, 0);
                if (s0 + s + 2 < npair) { const int o = 64 * (s0 + s + 2);
#pragma unroll
                    for (int i = 0; i < 4; ++i) { a[s][i][0] = *(const bf16x8*)(ap[i] + o); a[s][i][1] = *(const bf16x8*)(ap[i] + o + 8); b[s][i][0] = *(const bf16x8*)(bp[i] + o); b[s][i][1] = *(const bf16x8*)(bp[i] + o + 8); } }
            }
        }
    }
    constexpr int PP = 68;
    LAS float* P = (LAS float*)lds;
    __syncthreads();
#pragma unroll
    for (int i = 0; i < 4; ++i)
#pragma unroll
        for (int j = 0; j < 4; ++j) *(LAS f32x4*)(P + ((wid * 64 + i * 16 + fr) * PP + j * 16 + 4 * fq)) = acc[i][j];
    __syncthreads();
#pragma unroll
    for (int q = 0; q < 2; ++q) { const int e = tid + 512 * q, row = e >> 4, c4 = (e & 15) * 4; f32x4 v = *(const LAS f32x4*)(P + row * PP + c4);
#pragma unroll
        for (int w = 1; w < 8; ++w) v += *(const LAS f32x4*)(P + (w * 64 + row) * PP + c4);
        ef(row, c4, v); }
}

__device__ __forceinline__ int fourier_true_row(int m) {
    if (m < NCTX) return m; const int mm = m - NCTX, b = mm >> 13, rem = mm & 8191, cc = rem >> 7, rr = rem & 127; return NCTX + b * SEQ + rr * 64 + cc; }
template <bool FOURIER> __device__ __forceinline__ void epi_residual4(const P& p, int layer, int row  , int n, f32x4 v) {
    f32x4 xv;
    if (FOURIER) xv = *(const f32x4*)(((row < NCTX) ? p.ctx + (size_t)row * D : p.x + (size_t)(row - NCTX) * D) + n);
    else { const u32x2 w = *(const u32x2*)((const bf16_t*)(p.ws + WS_X2) + (size_t)row * D + n); xv = (f32x4){bf2f(w.x & 0xffffu), bf2f(w.x >> 16), bf2f(w.y & 0xffffu), bf2f(w.y >> 16)}; }
    const f32x4 gv = *(const f32x4*)(modp(p, layer, row_cond(row), 2) + n);
    st_bf4((bf16_t*)(p.ws + WS_X1) + (size_t)row * D + n, xv + gv * v); }
__device__ __forceinline__ void epi_hgrn4(const P& p, size_t row, int n  , f32x4 v) {
    const int seg = n >> 10, col = n & 1023;
    if (seg == 0) { f32x4 o; for (int j = 0; j < 4; ++j) o[j] = siluf_(v[j]); st_bf4((bf16_t*)(p.ws + WS_QB) + row * D + col, o); }
    else if (seg == 1 || seg == 2) { const f32x4 l4 = *(const f32x4*)((const float*)(p.ws + WS_LB) + (seg - 1) * D + col);
        typedef _Float16 h4 __attribute__((ext_vector_type(4))); h4 aa;
        for (int j = 0; j < 4; ++j) { const float s = __builtin_amdgcn_rcpf(1.f + __expf(-v[j])); const float fg = l4[j] + (1.f - l4[j]) * s; aa[j] = (_Float16)__logf(fg); }
        *(h4*)((_Float16*)(p.ws + (seg == 1 ? WS_AFW : WS_ABW)) + row * D + col) = aa; }
    else if (seg == 3) st_bf4((bf16_t*)(p.ws + WS_VB) + row * D + col, v);
    else { f32x4 o; for (int j = 0; j < 4; ++j) o[j] = siluf_(v[j]); st_bf4((bf16_t*)(p.ws + WS_SGB) + row * D + col, o); } }
struct KEpiBf16 { bf16_t* C; size_t ld; __device__ __forceinline__ void operator()(int r, int c, f32x4 v) const { st_bf4(C + (size_t)r * ld + c, v); } };
struct KEpiResF { const P* p; int row0, n0; __device__ __forceinline__ void operator()(int r, int c, f32x4 v) const { epi_residual4<true>(*p, 0, row0 + r, n0 + c, v); } };
struct KEpiHgrn { const P* p; int row0, n0; __device__ __forceinline__ void operator()(int r, int c, f32x4 v) const { epi_hgrn4(*p, (size_t)(row0 + r), n0 + c, v); } };

struct SchedDense { const char* A; const char* B; int RB, nM, nN, G, bid;
    __device__ __forceinline__ bool next(int i, pg8::GUnit& u) const { const int nwg = nM * nN; const long L = (long)i * G + bid; if (L >= nwg) return false;
        int wgid = (int)L; { const int q = nwg / 8, r = nwg % 8, xcd = wgid % 8, off = wgid / 8; wgid = (xcd < r ? xcd * (q + 1) : r * (q + 1) + (xcd - r) * q) + off; }
        const int nig = 8 * nN, gid = wgid / nig, fm = gid * 8, gsz = (nM - fm) < 8 ? (nM - fm) : 8; const int pm = fm + ((wgid % nig) % gsz), pn = (wgid % nig) / gsz;
        u.a = A + (size_t)pm * 256 * RB; u.b0 = B + (size_t)pn * 256 * RB; u.b1 = u.b0 + (size_t)128 * RB; u.e0 = pm * 256; u.e1 = pn * 256; u.e2 = 0; u.e3 = 0; return true; }
    __device__ __forceinline__ unsigned a_off(int, const pg8::GUnit&, int R) const { return (unsigned)R * (unsigned)RB; } };
template <bool FOURIER> struct EpiResidualP { static constexpr bool PERM = false; static constexpr int VM_OPS = 0; const P* p; int layer;
    __device__ __forceinline__ void operator()(const f32x4 (&acc)[2][2][4][2], const pg8::GUnit& u, int wr, int wc, int fr, int fq) const {
#pragma unroll
        for (int ai = 0; ai < 2; ++ai)
#pragma unroll
            for (int m = 0; m < 4; ++m) { const int mrow = NCTX + u.e0 + ai * 128 + wr * 64 + m * 16 + fr; const int row = FOURIER ? fourier_true_row(mrow) : mrow;
#pragma unroll
                for (int bj = 0; bj < 2; ++bj)
#pragma unroll
                    for (int n = 0; n < 2; ++n) epi_residual4<FOURIER>(*p, layer, row, u.e1 + bj * 128 + wc * 32 + n * 16 + 4 * fq, acc[ai][bj][m][n]); }
    } };
__device__ __forceinline__ float fast_silu(float v) { return v * __builtin_amdgcn_rcpf(1.f + __expf(-v)); }
__device__ __forceinline__ void epi_hgrn4_lds(const P& p, const LAS float* lbl, size_t row, int n  , f32x4 v) {
    const int seg = n >> 10, col = n & 1023;
    if (seg == 0) { f32x4 o; for (int j = 0; j < 4; ++j) o[j] = fast_silu(v[j]); st_bf4((bf16_t*)(p.ws + WS_QB) + row * D + col, o); }
    else if (seg == 1 || seg == 2) { const f32x4 l4 = *(const LAS f32x4*)(lbl + (seg - 1) * D + col);
        typedef _Float16 h4 __attribute__((ext_vector_type(4))); h4 aa;
        for (int j = 0; j < 4; ++j) { const float sg = __builtin_amdgcn_rcpf(1.f + __expf(-v[j])); const float fg = l4[j] + (1.f - l4[j]) * sg; aa[j] = (_Float16)__logf(fg); }
        *(h4*)((_Float16*)(p.ws + (seg == 1 ? WS_AFW : WS_ABW)) + row * D + col) = aa; }
    else if (seg == 3) st_bf4((bf16_t*)(p.ws + WS_VB) + row * D + col, v);
    else { f32x4 o; for (int j = 0; j < 4; ++j) o[j] = fast_silu(v[j]); st_bf4((bf16_t*)(p.ws + WS_SGB) + row * D + col, o); } }
struct EpiHgrnP { static constexpr bool PERM = true; static constexpr int VM_OPS = 16;
    const P* p; const LAS float* lbl;
    __device__ __forceinline__ void operator()(const f32x4 (&acc)[2][2][4][2], const pg8::GUnit& u, int wr, int wc, int fr, int fq) const {
#pragma unroll
        for (int ai = 0; ai < 2; ++ai)
#pragma unroll
            for (int m = 0; m < 4; ++m) { const size_t row = (size_t)(NCTX + u.e0 + ai * 128 + wr * 64 + m * 16 + fr);
#pragma unroll
                for (int bj = 0; bj < 2; ++bj)
#pragma unroll
                    for (int n = 0; n < 2; ++n) epi_hgrn4_lds(*p, lbl, row, u.e1 + bj * 128 + wc * 32 + 8 * fq + 4 * n, acc[ai][bj][m][n] * (1.f / W_SCALE)); }
    } };

__device__ __forceinline__ void ph_fprep1(const P& p, LAS unsigned char* lds) {
    for (int u = blockIdx.x; u < 512; u += gridDim.x) { const int type = u >> 8, g = (u >> 6) & 3, mt = (u >> 2) & 15, nt = u & 3;
        RowsDense af{(const bf16_t*)(p.ws + WS_WINB) + (size_t)(mt * 64) * D + g * 256, D};
        RowsDense bf{(const bf16_t*)(p.ws + WS_TAB + (type ? TAB_S256 : TAB_C256)) + (size_t)(nt * 64) * 256, 256};
        KEpiBf16 ef{(bf16_t*)(p.ws + WS_TAB2) + (size_t)(type * D + mt * 64) * D + g * 256 + nt * 64, D};
        kgemm_unit(lds, af, bf, ef, 256); }
}
__device__ __forceinline__ void ph_fprep2(const P& p, LAS unsigned char* lds) {
    for (int u = blockIdx.x; u < 512; u += gridDim.x) { const int mt = u >> 5, nt = u & 31;
        RowsDense af{(const bf16_t*)(p.ws + WS_WOUTT) + (size_t)(mt * 64) * D, D};
        RowsDense bf{(const bf16_t*)(p.ws + WS_TAB2) + (size_t)(nt * 64) * D, D};
        KEpiBf16 ef{(bf16_t*)(p.ws + WS_WABT) + (size_t)(mt * 64) * 2 * D + nt * 64, 2 * D};
        kgemm_unit(lds, af, bf, ef, D); }
}
__device__ __forceinline__ int xt_swz(int col) { return ((col >> 2) + 2 * (col & 3)) & 7; }
__device__ __forceinline__ void ph_mod1_cdft(const P& p, LAS unsigned char* lds) {
    const int tid = TIDX, lane = tid & 63, wave = tid >> 6, G = gridDim.x, bid = blockIdx.x;
    bf16_t* Hb = (bf16_t*)(p.ws + WS_HB); bf16_t* Z1 = (bf16_t*)(p.ws + WS_Z1); const bf16_t* tb = (const bf16_t*)(p.ws + WS_TAB);
    { const int gw = bid * 8 + wave, NGW = G * 8; RowVec a, sh; ld_modvec(p, p.norm1_g, 0, 2, 0, lane, a, sh);
      for (int row = gw; row < NCTX; row += NGW) { RowVec x = ld_row_f32(p.ctx + (size_t)row * D, lane); const float rs = row_rs(x);
#pragma unroll
          for (int j = 0; j < 4; ++j) x.v[j] = x.v[j] * rs * a.v[j] + sh.v[j];
          st_row_bf16(Hb + (size_t)row * D, lane, x); } }
    DftT<64, false> T; dft_load_t<64, false>(T, tb + TAB_T64 / 2, nullptr);
    for (int u = bid; u < NBATCH * 128; u += G) { const int b = u >> 7, r = u & 127;
        RowVec a, sh; ld_modvec(p, p.norm1_g, 0, b, 0, lane, a, sh);
        const float* xb = p.x + ((size_t)b * SEQ + r * 64 + wave * 8) * D;
        unsigned pk[4][4][4];
#pragma unroll
        for (int tp = 0; tp < 4; ++tp) { const RowVec x0 = ld_row_f32(xb + (size_t)(2 * tp) * D, lane), x1 = ld_row_f32(xb + (size_t)(2 * tp + 1) * D, lane);
            const float rs0 = row_rs(x0), rs1 = row_rs(x1);
#pragma unroll
            for (int j = 0; j < 4; ++j) { const f32x4 h0 = x0.v[j] * rs0 * a.v[j] + sh.v[j], h1 = x1.v[j] * rs1 * a.v[j] + sh.v[j];
#pragma unroll
                for (int e = 0; e < 4; ++e) pk[j][e][tp] = pk2(h0[e], h1[e]); }
            asm volatile("" ::: "memory"); }
        __syncthreads();
        { int tw = threadIdx.x; asm volatile("" : "+v"(tw)); const int lz = tw & 63, wz = tw >> 6;
#pragma unroll
          for (int j = 0; j < 4; ++j)
#pragma unroll
            for (int e = 0; e < 4; ++e) { const int col = 256 * j + 4 * lz + e;
                *(LAS u32x4*)(lds + col * 128 + ((wz ^ xt_swz(col)) << 4)) = (u32x4){pk[j][e][0], pk[j][e][1], pk[j][e][2], pk[j][e][3]}; } }
        lds_barrier();
        int tz = threadIdx.x; asm volatile("" : "+v"(tz));
        const int fr = tz & 15, fq = (tz >> 4) & 3, m = (tz >> 6) * 16 + fr; bf16_t* orow = Z1 + (size_t)(NCTX + b * SEQ + r) * 2 * D + (size_t)(m & 63) * 128 * 2 * D + (m >= 64 ? D : 0);
        CvtRegs cr; bool cv = false;
#pragma unroll 1
        for (int cb = 0; cb < 16; ++cb) {
            if ((cb & 1) == 0 && cb < 6) cv = bg_issue(cr, p, 0, cb >> 1);
            f32x4 acc[4];
#pragma unroll
            for (int ni = 0; ni < 4; ++ni) acc[ni] = (f32x4){0.f, 0.f, 0.f, 0.f};
#pragma unroll
            for (int ks = 0; ks < 2; ++ks)
#pragma unroll
                for (int ni = 0; ni < 4; ++ni) { const int col = cb * 64 + ni * 16 + fr; const bf16x8 xf = *(const LAS bf16x8*)(lds + col * 128 + (((ks * 4 + fq) ^ xt_swz(col)) << 4));
                    acc[ni] = __builtin_amdgcn_mfma_f32_16x16x32_bf16(xf, T.t[0][ks][0], acc[ni], 0, 0, 0); }
#pragma unroll
            for (int ni = 0; ni < 4; ++ni) st_bf4(orow + cb * 64 + ni * 16 + 4 * fq, acc[ni]);
            if ((cb & 1) == 1 && cv) { bg_finish(cr, p, 0, cb >> 1); cv = false; } }
    }
    __syncthreads();
}
__device__ __forceinline__ void ph_ctxdft(const P& p, LAS unsigned char* lds) {
    const bf16_t* Hb = (const bf16_t*)(p.ws + WS_HB); bf16_t* Z = (bf16_t*)(p.ws + WS_Z); const bf16_t* tb = (const bf16_t*)(p.ws + WS_TAB);
    for (int u = blockIdx.x; u < 32; u += gridDim.x) { const int b = u >> 4, cb = u & 15; DftRegs<256, false> xr;
        dft_fetch<256, false>(xr, Hb + (size_t)(b * CTXL) * D + cb * 64, nullptr, D);
        __syncthreads(); dft_stage<256, false>(lds, xr); __syncthreads();
        dft_compute_stream<256>(lds, tb + TAB_T256 / 2, Z + (size_t)(b * CTXL) * 2 * D + cb * 64, 2 * D); }
    __syncthreads();
}
__device__ __forceinline__ void ph_rdft(const P& p, LAS unsigned char* lds) {
    const bf16_t* Z1 = (const bf16_t*)(p.ws + WS_Z1); bf16_t* Z = (bf16_t*)(p.ws + WS_Z); const bf16_t* tb = (const bf16_t*)(p.ws + WS_TAB); const int G = gridDim.x;
    DftT<128, true> T; dft_load_t<128, true>(T, tb + TAB_T128A / 2, tb + TAB_T128B / 2);
    DftRegs<128, true> xr; int u = blockIdx.x;
    auto base = [&](int v) { const int b = v >> 10, cc = (v >> 4) & 63, cb = v & 15; return (size_t)(NCTX + b * SEQ + cc * 128) * 2 * D + cb * 64; };
    if (u < 2048) dft_fetch<128, true>(xr, Z1 + base(u), Z1 + base(u) + D, 2 * D);
    __syncthreads();
    for (int it = 0; u < 2048; u += G, ++it) { LAS unsigned char* buf = lds + (it & 1) * 40960;
        dft_stage<128, true>(buf, xr);
        if (u + G < 2048) dft_fetch<128, true>(xr, Z1 + base(u + G), Z1 + base(u + G) + D, 2 * D);
        CvtRegs cr; const bool cv = ((it & 1) == 1) && (it < 8) && bg_issue(cr, p, 0, 3 + (it >> 1));
        lds_barrier();
        dft_compute<128, true>(buf, T, Z + base(u), 2 * D);
        if (cv) bg_finish(cr, p, 0, 3 + (it >> 1)); }
    __syncthreads();
}
__device__ __forceinline__ void ph_gemm_f(const P& p, LAS unsigned char* lds) {
    for (int u = blockIdx.x; u < 128; u += gridDim.x) { const int mt = u >> 4, nt = u & 15;
        RowsDense af{(const bf16_t*)(p.ws + WS_Z) + (size_t)(mt * 64) * 2 * D, 2 * D};
        RowsDense bf{(const bf16_t*)(p.ws + WS_WABT) + (size_t)(nt * 64) * 2 * D, 2 * D};
        KEpiResF ef{&p, mt * 64, nt * 64};
        kgemm_unit(lds, af, bf, ef, 2 * D); }
    __syncthreads();
    SchedDense S{(const char*)(p.ws + WS_Z) + (size_t)NCTX * 2 * D * 2, (const char*)(p.ws + WS_WABT), 4 * D, NLAT / 256, D / 256, (int)gridDim.x, (int)blockIdx.x};
    EpiResidualP<true> E{&p, 0};
    pg8::gemm_phase<EpiResidualP<true>, SchedDense>(lds, 4 * D, S, E);
}

__device__ __forceinline__ void ph_gemm_hi(const P& p, LAS unsigned char* lds) {
    for (int u = blockIdx.x; u < 384; u += gridDim.x) { const int mt = u / 48, nt = 16 + u % 48;
        RowsDense af{(const bf16_t*)(p.ws + WS_HB) + (size_t)(mt * 64) * D, D};
        RowsDense bf{(const bf16_t*)(p.ws + WS_WHIT) + (size_t)(nt * 64) * D, D};
        KEpiHgrn ef{&p, mt * 64, nt * 64};
        kgemm_unit(lds, af, bf, ef, D); }
    LAS float* lbl = (LAS float*)(lds + LDS_BT);
    for (int q = TIDX; q < 2048; q += 512) lbl[q] = ((const float*)(p.ws + WS_LB))[q];
    __syncthreads();
    SchedDense S{(const char*)(p.ws + WS_HBH8) + (size_t)NCTX * D, (const char*)(p.ws + WS_WHIT8), D, NLAT / 256, NHI / 256, (int)gridDim.x, (int)blockIdx.x};
    EpiHgrnP E{&p, lbl};
    pg8::gemm_phase<EpiHgrnP, SchedDense, true>(lds, D, S, E);
}
__device__ __forceinline__ void ph_gemm_ho(const P& p, LAS unsigned char* lds) {
    SchedDense S{(const char*)(p.ws + WS_YR), (const char*)(p.ws + WS_WHOT), 2 * D, NLAT / 256, D / 256, (int)gridDim.x, (int)blockIdx.x};
    EpiResidualP<false> E{&p, 1};
    pg8::gemm_phase<EpiResidualP<false>, SchedDense>(lds, 2 * D, S, E);
}
constexpr int SC_QD = 0, SC_KG = 8704, SC_KT = 17408, SC_VT = 27648, SC_ET = 37888, SC_SET = 38400;
__device__ __forceinline__ int scan_pos(int ch) { const int kl = ch & 31; return (ch & ~31) + ((kl < 16) ? 8 * (kl >> 2) + (kl & 3) : 8 * ((kl - 16) >> 2) + 4 + (kl & 3)); }
template <bool OUTPUT>
__device__ __forceinline__ void scan_unit_mfma(const P& p, int unit, LAS unsigned char* lds) {
    const int tid = TIDX, lane = tid & 63, wid = __builtin_amdgcn_readfirstlane(tid >> 6), fr = lane & 15, fq = lane >> 4;
    const int ch = wid * 16 + fr, g = fq;
    const int stream = unit >> 3, part = unit & 7, b = stream >> 4, h = (stream >> 1) & 7, dir = stream & 1;
    int p0, nchunk;
    if (!OUTPUT) { if (part == 0) { p0 = 0; nchunk = CTXL / 32; } else { p0 = CTXL + (part - 1) * 1024; nchunk = 32; } }
    else { p0 = CTXL + part * 1024; nchunk = 32; }
    const _Float16* Ab = (const _Float16*)(p.ws + (dir ? WS_ABW : WS_AFW)) + h * HD + ch;
    const bf16_t* Vb = (const bf16_t*)(p.ws + WS_VB) + h * HD + ch; const bf16_t* Qb = (const bf16_t*)(p.ws + WS_QB) + h * HD + ch;
    float* Sloc = (float*)(p.ws + WS_SLOC); float* Dsum = (float*)(p.ws + WS_DSUM);
    f32x4 S[8];
#pragma unroll
    for (int kt = 0; kt < 8; ++kt) S[kt] = (f32x4){0.f, 0.f, 0.f, 0.f};
    if (OUTPUT) {
        for (int u = 0; u <= part; ++u) { const float* sl = Sloc + ((size_t)(stream * 8 + u) * 128) * 128 + wid * 16 + fr; const float* dd = Dsum + (size_t)(stream * 8 + u) * 128;
#pragma unroll
            for (int kt = 0; kt < 8; ++kt)
#pragma unroll
                for (int r = 0; r < 4; ++r) { const int k = kt * 16 + 4 * fq + r; S[kt][r] = __expf(dd[k]) * S[kt][r] + sl[(size_t)k * 128]; } } }
    float tsum = 0.f;
    auto rowof = [&](int pp) -> int { if (pp < CTXL) return b * CTXL + (dir ? CTXL - 1 - pp : pp); const int q = pp - CTXL; return NCTX + b * SEQ + (dir ? SEQ - 1 - q : q); };
    const int step = dir ? -1 : 1;
    const int sp0 = (g < 2) ? 16 * g : 16 * (g - 2) + 4, sp1 = sp0 + 8;
    const int kpos = scan_pos(ch);
    LAS unsigned char* scr = lds + 2 * SC_SET + wid * 3072;
    const int ft = lane >> 1, fh = lane & 1;
    const size_t foff = (size_t)h * HD + wid * 16 + fh * 8;
    const _Float16* Ag = (const _Float16*)(p.ws + (dir ? WS_ABW : WS_AFW)); const bf16_t* Vg = (const bf16_t*)(p.ws + WS_VB); const bf16_t* Qg = (const bf16_t*)(p.ws + WS_QB);
    u32x4 fa, fv, fqv = {0u, 0u, 0u, 0u};
    { const size_t o = (size_t)rowof(p0 + ft) * D + foff; fa = *(const u32x4*)(Ag + o); fv = *(const u32x4*)(Vg + o); if (OUTPUT) fqv = *(const u32x4*)(Qg + o); }
    __syncthreads();
    for (int ci = 0; ci < nchunk; ++ci) {
        LAS unsigned char* set = lds + (ci & 1) * SC_SET;
        *(LAS u32x4*)(scr + lane * 16) = fa; *(LAS u32x4*)(scr + 1024 + lane * 16) = fv; if (OUTPUT) *(LAS u32x4*)(scr + 2048 + lane * 16) = fqv;
        if (ci + 1 < nchunk) { const size_t o = (size_t)rowof(p0 + 32 * (ci + 1) + ft) * D + foff; fa = *(const u32x4*)(Ag + o); fv = *(const u32x4*)(Vg + o); if (OUTPUT) fqv = *(const u32x4*)(Qg + o); }
        CvtRegs cr; const int cslot = ci >> 2;
        const bool cv = OUTPUT && (ci & 3) == 2 && ci < 28 && bg_issue(cr, p, 1, cslot);
        asm volatile("" ::: "memory");
        _Float16 av[8]; bf16_t qv[8], vv[8];
#pragma unroll
        for (int j = 0; j < 8; ++j) { const int so = (8 * g + j) * 32 + fr * 2; av[j] = *(const LAS _Float16*)(scr + so); vv[j] = *(const LAS bf16_t*)(scr + 1024 + so); if (OUTPUT) qv[j] = *(const LAS bf16_t*)(scr + 2048 + so); else qv[j] = 0; }
        float c[8]; float run = 0.f;
#pragma unroll
        for (int j = 0; j < 8; ++j) { run += (float)av[j]; c[j] = run; }
        float incl = run; { const float u1 = __shfl_up(incl, 16); if (g >= 1) incl += u1; const float u2 = __shfl_up(incl, 32); if (g >= 2) incl += u2; }
        const float m = incl - run, T = __shfl(incl, 48 + fr);
        { unsigned kd[4], vp[4];
#pragma unroll
          for (int j2 = 0; j2 < 4; ++j2) { float kdv[2];
#pragma unroll
              for (int e = 0; e < 2; ++e) { const int j = 2 * j2 + e; const float cf = m + c[j]; const float kk = 1.f - __expf((float)av[j]); kdv[e] = kk * __expf(T - cf);
                  if (OUTPUT) { const float e1 = __expf(cf); const float qd = bf2f(qv[j]) * e1; const float kg = kk * __expf(fminf(-cf, 80.f)); const int t = 8 * g + j;
                      *(LAS bf16_t*)(set + SC_QD + t * 272 + kpos * 2) = (bf16_t)f2bf(qd); *(LAS bf16_t*)(set + SC_KG + t * 272 + kpos * 2) = (bf16_t)f2bf(kg); } }
              kd[j2] = pk2(kdv[0], kdv[1]); vp[j2] = (unsigned)vv[2 * j2] | ((unsigned)vv[2 * j2 + 1] << 16); }
          *(LAS u32x2*)(set + SC_KT + ch * 80 + sp0 * 2) = (u32x2){kd[0], kd[1]}; *(LAS u32x2*)(set + SC_KT + ch * 80 + sp1 * 2) = (u32x2){kd[2], kd[3]};
          *(LAS u32x2*)(set + SC_VT + ch * 80 + sp0 * 2) = (u32x2){vp[0], vp[1]}; *(LAS u32x2*)(set + SC_VT + ch * 80 + sp1 * 2) = (u32x2){vp[2], vp[3]}; }
        if (g == 0) { *(LAS float*)(set + SC_ET + ch * 4) = __expf(T); tsum += T; }
        lds_barrier();
        const bf16x8 vfrag = *(const LAS bf16x8*)(set + SC_VT + (wid * 16 + fr) * 80 + fq * 16);
        if (OUTPUT) {
            bf16x8 bq[2][4];
#pragma unroll
            for (int tt = 0; tt < 2; ++tt)
#pragma unroll
                for (int ks = 0; ks < 4; ++ks) bq[tt][ks] = *(const LAS bf16x8*)(set + SC_QD + (tt * 16 + fr) * 272 + ks * 64 + fq * 16);
            f32x4 p00 = (f32x4){0.f, 0.f, 0.f, 0.f}, p01 = p00, p11 = p00;
#pragma unroll
            for (int ks = 0; ks < 4; ++ks) { const bf16x8 ak0 = *(const LAS bf16x8*)(set + SC_KG + fr * 272 + ks * 64 + fq * 16), ak1 = *(const LAS bf16x8*)(set + SC_KG + (16 + fr) * 272 + ks * 64 + fq * 16);
                p00 = __builtin_amdgcn_mfma_f32_16x16x32_bf16(ak0, bq[0][ks], p00, 0, 0, 0); p01 = __builtin_amdgcn_mfma_f32_16x16x32_bf16(ak0, bq[1][ks], p01, 0, 0, 0);
                p11 = __builtin_amdgcn_mfma_f32_16x16x32_bf16(ak1, bq[1][ks], p11, 0, 0, 0); }
#pragma unroll
            for (int r = 0; r < 4; ++r) if (4 * fq + r > fr) { p00[r] = 0.f; p11[r] = 0.f; }
            f32x4 oacc[2]; oacc[0] = (f32x4){0.f, 0.f, 0.f, 0.f}; oacc[1] = oacc[0];
#pragma unroll
            for (int ks = 0; ks < 4; ++ks) { union { u32x4 u; bf16x8 v; } sa; sa.u = (u32x4){pk2(S[2 * ks][0], S[2 * ks][1]), pk2(S[2 * ks][2], S[2 * ks][3]), pk2(S[2 * ks + 1][0], S[2 * ks + 1][1]), pk2(S[2 * ks + 1][2], S[2 * ks + 1][3])};
#pragma unroll
                for (int tt = 0; tt < 2; ++tt) oacc[tt] = __builtin_amdgcn_mfma_f32_16x16x32_bf16(sa.v, bq[tt][ks], oacc[tt], 0, 0, 0); }
            { union { u32x4 u; bf16x8 v; } pb0, pb1; pb0.u = (u32x4){pk2(p00[0], p00[1]), pk2(p00[2], p00[3]), 0u, 0u}; pb1.u = (u32x4){pk2(p01[0], p01[1]), pk2(p01[2], p01[3]), pk2(p11[0], p11[1]), pk2(p11[2], p11[3])};
              oacc[0] = __builtin_amdgcn_mfma_f32_16x16x32_bf16(vfrag, pb0.v, oacc[0], 0, 0, 0); oacc[1] = __builtin_amdgcn_mfma_f32_16x16x32_bf16(vfrag, pb1.v, oacc[1], 0, 0, 0); }
            bf16_t* Ob = (bf16_t*)(p.ws + (dir ? WS_OBW : WS_OFW));
#pragma unroll
            for (int tt = 0; tt < 2; ++tt) { const int row = rowof(p0 + 32 * ci + tt * 16 + fr) - NCTX; st_bf4(Ob + (size_t)row * D + h * HD + wid * 16 + 4 * fq, oacc[tt]); }
        }
#pragma unroll
        for (int kt = 0; kt < 8; ++kt) { const f32x4 e4 = *(const LAS f32x4*)(set + SC_ET + (kt * 16 + 4 * fq) * 4); S[kt] = S[kt] * e4;
            const bf16x8 ak = *(const LAS bf16x8*)(set + SC_KT + (kt * 16 + fr) * 80 + fq * 16); S[kt] = __builtin_amdgcn_mfma_f32_16x16x32_bf16(ak, vfrag, S[kt], 0, 0, 0); }
        if (cv) bg_finish(cr, p, 1, cslot);
    }
    if (!OUTPUT) { float* sl = Sloc + ((size_t)(stream * 8 + part) * 128) * 128 + wid * 16 + fr;
#pragma unroll
        for (int kt = 0; kt < 8; ++kt)
#pragma unroll
            for (int r = 0; r < 4; ++r) sl[(size_t)(kt * 16 + 4 * fq + r) * 128] = S[kt][r];
        if (g == 0) Dsum[(size_t)(stream * 8 + part) * 128 + ch] = tsum; }
    __syncthreads();
}

__device__ __forceinline__ void ph_readout(const P& p) {
    const int lane = TIDX & 63, gw = blockIdx.x * 8 + (TIDX >> 6), NGW = gridDim.x * 8;
    const bf16_t* Of = (const bf16_t*)(p.ws + WS_OFW); const bf16_t* Ob = (const bf16_t*)(p.ws + WS_OBW); const bf16_t* SG = (const bf16_t*)(p.ws + WS_SGB) + (size_t)NCTX * D; bf16_t* Yr = (bf16_t*)(p.ws + WS_YR);
    const RowVec ng = ld_row_f32(p.h_norm_g, lane);
    u32x2 an[4], cn[4], gn[4];
#define RO_LOAD(rr) do { _Pragma("unroll") for (int j = 0; j < 4; ++j) { const size_t off_ = (size_t)(rr) * D + 256 * j + 4 * lane; an[j] = *(const u32x2*)(Of + off_); cn[j] = *(const u32x2*)(Ob + off_); gn[j] = *(const u32x2*)(SG + off_); } } while (0)
    if (gw < NLAT) RO_LOAD(gw);
    for (int r = gw; r < NLAT; r += NGW) { RowVec o; u32x2 a4[4], c4[4], g4[4];
#pragma unroll
        for (int j = 0; j < 4; ++j) { a4[j] = an[j]; c4[j] = cn[j]; g4[j] = gn[j]; }
        if (r + NGW < NLAT) RO_LOAD(r + NGW);
#pragma unroll
        for (int j = 0; j < 4; ++j) { const u32x2 a = a4[j], c = c4[j], g = g4[j];
            f32x4 v; v.x = bf2f(a.x & 0xffffu) + bf2f(c.x & 0xffffu); v.y = bf2f(a.x >> 16) + bf2f(c.x >> 16); v.z = bf2f(a.y & 0xffffu) + bf2f(c.y & 0xffffu); v.w = bf2f(a.y >> 16) + bf2f(c.y >> 16);
            float s = (v.x * v.x + v.y * v.y) + (v.z * v.z + v.w * v.w);
#pragma unroll
            for (int q = 1; q < 32; q <<= 1) s += __shfl_xor(s, q);
            const float rs = rsqrtf(s * (1.f / HD) + EPS);
            f32x4 gg; gg.x = bf2f(g.x & 0xffffu); gg.y = bf2f(g.x >> 16); gg.z = bf2f(g.y & 0xffffu); gg.w = bf2f(g.y >> 16);
            o.v[j] = v * rs * ng.v[j] * gg; }
        st_row_bf16(Yr + (size_t)r * D, lane, o); }
#undef RO_LOAD
}

#define XB_TMO      128
#define XB_XCNT(j)  (256  + 64 * (j))
#define XB_XSUB(j)  (1280 + 64 * (j))
#define XB_XGEN(j)  (2304 + 64 * (j))
#define XB_TOP      3328
#define XB_TOPGEN   3392
#define XCD_BAR_WORDS 3456
#define XB_SPIN_CAP (1u << 18)
__device__ __forceinline__ unsigned xb_ld(unsigned* p)              { return __hip_atomic_load(p, __ATOMIC_RELAXED, __HIP_MEMORY_SCOPE_AGENT); }
__device__ __forceinline__ unsigned xb_add(unsigned* p, unsigned v) { return __hip_atomic_fetch_add(p, v, __ATOMIC_RELAXED, __HIP_MEMORY_SCOPE_AGENT); }
__device__ __forceinline__ unsigned xb_xcc_id() { return (unsigned)__builtin_amdgcn_s_getreg((3 << 11) | 20) & 0xFu; }
#define XB_SPIN(cond, bar) do { unsigned _sp = 0; while (cond) { __builtin_amdgcn_s_sleep(1); \
    if ((++_sp & 255u) == 0u) { if (xb_ld(&(bar)[XB_TMO])) break; if (_sp > XB_SPIN_CAP) { atomicAdd(&(bar)[XB_TMO], 1u); break; } } } } while (0)
struct XcdBarrier { unsigned* bar; unsigned x; volatile LAS unsigned* st; };
__device__ __forceinline__ XcdBarrier xcd_barrier_post(unsigned* bar, volatile LAS unsigned* st) {
    XcdBarrier b; b.bar = bar; b.x = xb_xcc_id(); b.st = st;
    if (threadIdx.x == 0) (void)xb_add(&bar[XB_XCNT(b.x)], 1u);
    return b;
}
__device__ __forceinline__ void xcd_barrier_complete(unsigned* bar, unsigned x, unsigned& nloc, unsigned& nx) {
    const unsigned G = gridDim.x * gridDim.y * gridDim.z;
    unsigned sum, cnt, mine, sp = 0u;
    for (;;) {
        sum = 0u; cnt = 0u; mine = 0u;
#pragma unroll
        for (unsigned j = 0; j < 16; ++j) { const unsigned c = xb_ld(&bar[XB_XCNT(j)]); sum += c; cnt += (c > 0u) ? 1u : 0u; mine = (j == x) ? c : mine; }
        if (sum == G) break;
        __builtin_amdgcn_s_sleep(1);
        if ((++sp & 255u) == 0u) { if (xb_ld(&bar[XB_TMO])) break; if (sp > XB_SPIN_CAP) { atomicAdd(&bar[XB_TMO], 1u); break; } }
    }
    nloc = mine > 0u ? mine : 1u; nx = cnt > 0u ? cnt : 1u;
}
__device__ __forceinline__ void xcd_barrier(const XcdBarrier& b) {
    asm volatile("s_waitcnt vmcnt(0)" ::: "memory");
    __syncthreads();
    if (threadIdx.x == 0) {
        unsigned* bar = b.bar;
        __builtin_amdgcn_s_waitcnt(0);
        unsigned nloc = b.st[0], nx = b.st[1];
        if (nloc == 0u) { xcd_barrier_complete(bar, b.x, nloc, nx); b.st[0] = nloc; b.st[1] = nx; }
        const unsigned old = xb_add(&bar[XB_XSUB(b.x)], 1u);
        const unsigned gen = old / nloc;
        if (old + 1u == (gen + 1u) * nloc) {
            __builtin_amdgcn_fence(__ATOMIC_RELEASE, "agent");
            asm volatile("s_waitcnt vmcnt(0)" ::: "memory");
            const unsigned og = xb_add(&bar[XB_TOP], 1u);
            const unsigned tg = og / nx;
            if (og + 1u == (tg + 1u) * nx) xb_add(&bar[XB_TOPGEN], 1u);
            else XB_SPIN(xb_ld(&bar[XB_TOPGEN]) == tg, bar);
            __builtin_amdgcn_fence(__ATOMIC_ACQUIRE, "agent");
            xb_add(&bar[XB_XGEN(b.x)], 1u);
            asm volatile("s_waitcnt vmcnt(0)" ::: "memory");
        } else {
            XB_SPIN(xb_ld(&bar[XB_XGEN(b.x)]) == gen, bar);
            __builtin_amdgcn_fence(__ATOMIC_ACQUIRE, "agent");
            asm volatile("s_waitcnt vmcnt(0)" ::: "memory");
        }
    }
    __syncthreads();
}

__global__ void __launch_bounds__(512, 2) fwd(Args args) {
    extern __shared__ __attribute__((aligned(16))) unsigned char lds_raw[];
    LAS unsigned char* lds = (LAS unsigned char*)lds_raw;
    P p;
    p.x = (const float*)args.in[0]; p.c = (const float*)args.in[1]; p.ctx = (const float*)args.in[2]; p.c_ctx = (const float*)args.in[3];
    p.mod_w = (const float*)args.in[4]; p.mod_b = (const float*)args.in[5]; p.norm1_g = (const float*)args.in[6]; p.norm2_g = (const float*)args.in[7];
    p.f_w_in = (const float*)args.in[8]; p.f_w_out = (const float*)args.in[9]; p.h_w_in = (const float*)args.in[10]; p.h_lb = (const float*)args.in[11];
    p.h_norm_g = (const float*)args.in[12]; p.h_w_out = (const float*)args.in[13]; p.router_w = (const float*)args.in[14]; p.router_b = (const float*)args.in[15];
    p.e_w1 = (const float*)args.in[16]; p.e_b1 = (const float*)args.in[17]; p.e_w2 = (const float*)args.in[18]; p.e_b2 = (const float*)args.in[19]; p.final_g = (const float*)args.in[20];
    p.out = args.out; p.ws = args.ws;
    const int lo = args.ph_lo, hi = args.ph_hi;
    volatile LAS unsigned* misc = (volatile LAS unsigned*)(lds + LDS_MISC);
    if (threadIdx.x < 4) misc[threadIdx.x] = 0u;
    __syncthreads();
    XcdBarrier bar = xcd_barrier_post((unsigned*)(p.ws + WS_CTL), misc);
#define IN(k) (lo <= (k) && (k) < hi)
#define SEAM(k) do { if (IN(k) && IN((k) + 1)) xcd_barrier(bar); } while (0)
    if (IN(0)) ph_prologue(p, lds);
    SEAM(0);
    if (IN(1)) { ph_mod1_cdft(p, lds); ph_fprep1(p, lds); }
    SEAM(1);
    if (IN(2)) { ph_ctxdft(p, lds); ph_rdft(p, lds); ph_fprep2(p, lds); }
    if (IN(2) && IN(4)) xcd_barrier(bar);
    if (IN(4)) ph_gemm_f(p, lds);
    SEAM(4);
    if (IN(5)) { bg_catchup(p, 0); ph_mod2_route(p, 0, lds); }
    SEAM(5);
    if (IN(6)) ph_moe1(p, 0, lds);
    SEAM(6);
    if (IN(7)) ph_moe2(p, 0, lds);
    SEAM(7);
    if (IN(8)) ph_combine(p, 0);
    SEAM(8);
    if (IN(9)) ph_gemm_hi(p, lds);
    SEAM(9);
    if (IN(10)) { for (int u = blockIdx.x; u < 256; u += gridDim.x) scan_unit_mfma<false>(p, u, lds); }
    SEAM(10);
    if (IN(11)) { for (int u = blockIdx.x; u < 256; u += gridDim.x) scan_unit_mfma<true>(p, u, lds); }
    SEAM(11);
    if (IN(12)) ph_readout(p);
    SEAM(12);
    if (IN(13)) ph_gemm_ho(p, lds);
    SEAM(13);
    if (IN(14)) { bg_catchup(p, 1); ph_mod2_route(p, 1, lds); }
    SEAM(14);
    if (IN(15)) ph_moe1(p, 1, lds);
    SEAM(15);
    if (IN(16)) ph_moe2(p, 1, lds);
    SEAM(16);
    if (IN(17)) ph_combine(p, 1);
#undef SEAM
#undef IN
}

extern "C" void kernel_launch(void* const* d_in, const int* in_sizes, int n_in, void* d_out, int out_size, void* d_ws, size_t ws_size, hipStream_t stream) {
    static int grid = 0;
    if (grid == 0) {
        if (n_in != 21 || out_size != NLAT * D || ws_size < WS_END) { fprintf(stderr, "kernel_launch: unexpected shapes (n_in %d out %d ws %zu)\n", n_in, out_size, ws_size); grid = -1; return; }
        int dev = 0, cus = 0, per_cu = 0;
        (void)hipGetDevice(&dev); (void)hipDeviceGetAttribute(&cus, hipDeviceAttributeMultiprocessorCount, dev);
        if (hipFuncSetAttribute((const void*)fwd, hipFuncAttributeMaxDynamicSharedMemorySize, LDS_BYTES) != hipSuccess) { fprintf(stderr, "kernel_launch: hipFuncSetAttribute failed\n"); grid = -1; return; }
        if (hipOccupancyMaxActiveBlocksPerMultiprocessor(&per_cu, (const void*)fwd, 512, LDS_BYTES) != hipSuccess || per_cu < 1) { fprintf(stderr, "kernel_launch: occupancy query says %d blocks per CU\n", per_cu); grid = -1; return; }
        (void)hipGetLastError();
        if (cus < 256) { fprintf(stderr, "kernel_launch: built for a 256-CU device (one resident workgroup per CU)\n"); grid = -1; return; }
        grid = 256;
    }
    if (grid < 0) return;
    (void)hipMemsetAsync((char*)d_ws + WS_CTL, 0, CTL_BYTES, stream);
    Args a{};
    for (int i = 0; i < 21; ++i) a.in[i] = d_in[i];
    a.out = (float*)d_out; a.ws = (unsigned char*)d_ws;
#ifndef N_LAUNCHES
#define N_LAUNCHES 1
#endif
    if (N_LAUNCHES == 1) { a.ph_lo = 0; a.ph_hi = NPH; hipLaunchKernelGGL(fwd, dim3(grid), dim3(512), LDS_BYTES, stream, a); }
    else for (int ph = 0; ph < NPH; ++ph) { a.ph_lo = ph; a.ph_hi = ph + 1; hipLaunchKernelGGL(fwd, dim3(grid), dim3(512), LDS_BYTES, stream, a); }
}
```

```cpp
#include <hip/hip_runtime.h>
#include <cstdio>
#include <cstdint>

#define LAS __attribute__((address_space(3)))
typedef unsigned short bf16_t;
typedef short bf16x8 __attribute__((ext_vector_type(8)));
typedef float f32x4 __attribute__((ext_vector_type(4)));
typedef float f32x2 __attribute__((ext_vector_type(2)));
typedef unsigned u32x4 __attribute__((ext_vector_type(4)));
typedef unsigned u32x2 __attribute__((ext_vector_type(2)));

constexpr int D = 1024, NBATCH = 2, SEQ = 8192, CTXL = 256;
constexpr int NCTX = NBATCH * CTXL;
constexpr int NLAT = NBATCH * SEQ;
constexpr int NTOK = NCTX + NLAT;
constexpr int NE = 32, DFF = 1024, NH = 8, HD = 128;
constexpr int NHI = 5 * D;
constexpr int MAXROWS = (((NTOK * 4) + 255) / 256 + NE) * 256;
constexpr float EPS = 1e-6f;
constexpr int NPH = 18;

constexpr size_t MiB = 1u << 20;
constexpr size_t WS_CTL = 0, CTL_BYTES = 16384 + 16384;
constexpr size_t CTL_CNT = 16384;
constexpr int CNT_STRIDE = 64;
constexpr size_t CTL_MOD = 128 * 1024;
constexpr size_t WS_LB = 1 * MiB;
constexpr size_t WS_TAB = 2 * MiB;
constexpr size_t TAB_T64 = 0, TAB_T128A = 16384, TAB_T128B = TAB_T128A + 65536, TAB_T256 = TAB_T128B + 65536,
                 TAB_C256 = TAB_T256 + 262144, TAB_S256 = TAB_C256 + 131072;
constexpr size_t WS_WINB = 4 * MiB, WS_WOUTT = 6 * MiB, WS_TAB2 = 8 * MiB, WS_WABT = 12 * MiB, WS_WHIT = 16 * MiB, WS_WHOT = 26 * MiB;
constexpr size_t WS_ROUTE = 28 * MiB;
constexpr size_t RT_LIST = 0, RT_ASGE = 2304 * 1024, RT_ASGP = RT_ASGE + 320 * 1024, RT_GATE = RT_ASGP + 320 * 1024;
constexpr size_t WS_W1T = 32 * MiB, WS_W2T = 288 * MiB;
constexpr size_t WS_HB = 416 * MiB, WS_X1 = 450 * MiB, WS_X2 = 516 * MiB, WS_Z1 = 582 * MiB, WS_Z = 648 * MiB;
constexpr size_t WS_ACT = 714 * MiB, WS_YB = 862 * MiB;
constexpr size_t WS_QB = 1010 * MiB, WS_KFW = 1044 * MiB, WS_KBW = 1078 * MiB, WS_VB = 1112 * MiB, WS_SGB = 1146 * MiB;
constexpr size_t WS_AFW = 1180 * MiB, WS_ABW = 1246 * MiB, WS_OFW = 1312 * MiB, WS_OBW = 1344 * MiB, WS_YR = 1376 * MiB;
constexpr size_t WS_Z8C = WS_Z;
constexpr size_t WS_Z8 = WS_Z + 4 * MiB;
constexpr size_t WS_WABT8 = WS_X2 + 40 * MiB;
constexpr size_t WS_HB8 = WS_KFW;
constexpr size_t WS_WHIT8 = WS_KBW;
constexpr size_t WS_HBH8 = WS_KBW + 8 * MiB;
constexpr size_t WS_SLOC = 1408 * MiB, WS_DSUM = 1424 * MiB, WS_END = 1426 * MiB;

constexpr int LDS_BYTES = 160 * 1024;
constexpr int LDS_MISC = LDS_BYTES - 1024;

struct P {
    const float *x, *c, *ctx, *c_ctx, *mod_w, *mod_b, *norm1_g, *norm2_g, *f_w_in, *f_w_out, *h_w_in, *h_lb, *h_norm_g, *h_w_out,
                *router_w, *router_b, *e_w1, *e_b1, *e_w2, *e_b2, *final_g;
    float* out; unsigned char* ws;
};
struct Args { float* out; unsigned char* ws; const void* in[21]; int ph_lo, ph_hi; };

typedef __bf16 bf16v2 __attribute__((ext_vector_type(2)));
__device__ __forceinline__ unsigned pk2(float lo, float hi) { const bf16v2 v = {(__bf16)lo, (__bf16)hi}; return __builtin_bit_cast(unsigned, v); }
__device__ __forceinline__ unsigned f2bf(float f) { return pk2(f, 0.f) & 0xffffu; }
__device__ __forceinline__ float bf2f(unsigned b) { return __uint_as_float(b << 16); }
__device__ __forceinline__ float sigmoidf_(float v) { return 1.f / (1.f + __expf(-v)); }
__device__ __forceinline__ float siluf_(float v) { return v / (1.f + __expf(-v)); }
__device__ __forceinline__ float wave_sum(float v) {
#pragma unroll
    for (int o = 1; o < 64; o <<= 1) v += __shfl_xor(v, o);
    return v;
}
#define LDS_WAIT() asm volatile("s_waitcnt lgkmcnt(0)" ::: "memory")
__device__ __forceinline__ int opaque_tid() { int t = threadIdx.x; asm volatile("" : "+v"(t)); return t; }
#define TIDX opaque_tid()
__device__ __forceinline__ void lds_barrier() { asm volatile("s_waitcnt lgkmcnt(0)" ::: "memory"); __builtin_amdgcn_s_barrier(); asm volatile("" ::: "memory"); }
constexpr float YB_SCALE = 16.f;
constexpr float W_SCALE = 64.f, ACT_SCALE = 4.f;
__device__ __forceinline__ unsigned pk4_fp8(float a, float b, float c, float d) { int w = 0; w = __builtin_amdgcn_cvt_pk_fp8_f32(a, b, w, false); w = __builtin_amdgcn_cvt_pk_fp8_f32(c, d, w, true); return (unsigned)w; }

__device__ __forceinline__ const float* modp(const P& p, int l, int c, int q) { return (const float*)(p.ws + CTL_MOD) + ((size_t)(l * 3 + c) * 6 + q) * D; }
__device__ __forceinline__ int row_cond(int row) { return row < NCTX ? 2 : ((row - NCTX) >> 13); }

__device__ __forceinline__ void transpose_item(const float* W, int K, int N, bf16_t* WT, LAS float* scr, int item, int lane) {
    const int nblk = N / 32, kb = item / nblk, nb = item % nblk, k0 = 64 * kb, n0 = 32 * nb;
#pragma unroll 8
    for (int i = 0; i < 32; ++i) { const int kk = 2 * i + (lane >> 5); scr[kk * 33 + (lane & 31)] = W[(size_t)(k0 + kk) * N + n0 + (lane & 31)]; }
    LDS_WAIT();
    const int c = lane & 7;
#pragma unroll
    for (int j = 0; j < 4; ++j) { const int n = (lane >> 3) + 8 * j; const LAS float* s = scr + (8 * c) * 33 + n;
        u32x4 o; o.x = pk2(s[0 * 33], s[1 * 33]); o.y = pk2(s[2 * 33], s[3 * 33]); o.z = pk2(s[4 * 33], s[5 * 33]); o.w = pk2(s[6 * 33], s[7 * 33]);
        *(u32x4*)(WT + (size_t)(n0 + n) * K + k0 + 8 * c) = o; }
    LDS_WAIT();
}

struct CvtRegs { f32x4 v[16]; };
__device__ __forceinline__ void cvt_issue(CvtRegs& r, const float* W, int N, int item, int lane) {
    const int nblk = N / 32, kb = item / nblk, nb = item % nblk; const float* src = W + (size_t)(128 * kb + 16 * (lane >> 3)) * N + 32 * nb + 4 * (lane & 7);
#pragma unroll
    for (int i = 0; i < 16; ++i) r.v[i] = __builtin_nontemporal_load((const f32x4*)(src + (size_t)i * N));
}
__device__ __forceinline__ void cvt_finish(const CvtRegs& r, unsigned char* WT, int K, int N, int item, int lane) {
    const int nblk = N / 32, kb = item / nblk, nb = item % nblk; unsigned o[4][4];
#pragma unroll
    for (int blk = 0; blk < 4; ++blk) { unsigned d[4];
#pragma unroll
        for (int e = 0; e < 4; ++e) { const f32x4 x = r.v[4 * blk + e] * W_SCALE; d[e] = pk4_fp8(x[0], x[1], x[2], x[3]); }
        const unsigned t0 = __builtin_amdgcn_perm(d[1], d[0], 0x05010400u), t1 = __builtin_amdgcn_perm(d[1], d[0], 0x07030602u);
        const unsigned t2 = __builtin_amdgcn_perm(d[3], d[2], 0x05010400u), t3 = __builtin_amdgcn_perm(d[3], d[2], 0x07030602u);
        o[0][blk] = __builtin_amdgcn_perm(t2, t0, 0x05040100u); o[1][blk] = __builtin_amdgcn_perm(t2, t0, 0x07060302u);
        o[2][blk] = __builtin_amdgcn_perm(t3, t1, 0x05040100u); o[3][blk] = __builtin_amdgcn_perm(t3, t1, 0x07060302u); }
    unsigned char* dst = WT + (size_t)(32 * nb + 4 * (lane & 7)) * K + 128 * kb + 16 * (lane >> 3);
#pragma unroll
    for (int j = 0; j < 4; ++j) __builtin_nontemporal_store((u32x4){o[j][0], o[j][1], o[j][2], o[j][3]}, (u32x4*)(dst + (size_t)j * K));
}
constexpr int CV_W1 = 8 * 64, CV_W2 = 8 * 32, CV_N1 = 64 * CV_W1, CV_NALL = CV_N1 + 64 * CV_W2;
__device__ __forceinline__ void cvt_item_issue(CvtRegs& r, const P& p, int it, int lane) {
    if (it < CV_N1) cvt_issue(r, p.e_w1 + (size_t)(it / CV_W1) * D * 2 * DFF, 2 * DFF, it % CV_W1, lane);
    else { const int q = it - CV_N1; cvt_issue(r, p.e_w2 + (size_t)(q / CV_W2) * DFF * D, D, q % CV_W2, lane); } }
__device__ __forceinline__ void cvt_item_finish(const CvtRegs& r, const P& p, int it, int lane) {
    if (it < CV_N1) cvt_finish(r, (unsigned char*)(p.ws + WS_W1T) + (size_t)(it / CV_W1) * D * 2 * DFF, D, 2 * DFF, it % CV_W1, lane);
    else { const int q = it - CV_N1; cvt_finish(r, (unsigned char*)(p.ws + WS_W2T) + (size_t)(q / CV_W2) * DFF * D, DFF, D, q % CV_W2, lane); } }

constexpr int BG_ITEMS = 32 * CV_W1 + 32 * CV_W2, BG_SLOTS = 12;
__device__ __forceinline__ int bg_item(int pool, int n) { return n < 32 * CV_W1 ? pool * 32 * CV_W1 + n : CV_N1 + pool * 32 * CV_W2 + (n - 32 * CV_W1); }
__device__ __forceinline__ bool bg_issue(CvtRegs& r, const P& p, int pool, int slot) { const int gw = blockIdx.x * 8 + (TIDX >> 6), n = slot * (int)gridDim.x * 8 + gw;
    if (n >= BG_ITEMS) return false; cvt_item_issue(r, p, bg_item(pool, n), TIDX & 63); return true; }
__device__ __forceinline__ void bg_finish(const CvtRegs& r, const P& p, int pool, int slot) { const int gw = blockIdx.x * 8 + (TIDX >> 6), n = slot * (int)gridDim.x * 8 + gw;
    cvt_item_finish(r, p, bg_item(pool, n), TIDX & 63); }
__device__ __forceinline__ void bg_catchup(const P& p, int pool) { const int NGW = gridDim.x * 8, gw = blockIdx.x * 8 + (TIDX >> 6); CvtRegs r;
    for (int n = BG_SLOTS * NGW + gw; n < BG_ITEMS; n += NGW) { cvt_item_issue(r, p, bg_item(pool, n), TIDX & 63); cvt_item_finish(r, p, bg_item(pool, n), TIDX & 63); } }

__device__ __forceinline__ void ph_prologue(const P& p, LAS unsigned char* lds) {
    const int tid = TIDX, lane = tid & 63, wave = tid >> 6, G = gridDim.x, bid = blockIdx.x;
    {
        LAS float* sc = (LAS float*)lds;
        LAS float* red = sc + 3 * D;
        __syncthreads();
        for (int e = tid; e < 3 * D; e += 512) { const int c = e >> 10, k = e & 1023; const float v = (c < 2) ? p.c[c * D + k] : p.c_ctx[k]; sc[e] = siluf_(v); }
        __syncthreads();
        const int cq = tid & 15, kg = tid >> 4;
        for (int it = bid; it < 192; it += G) {
            const int l = it / 96, cb = it % 96;
            const float* w = p.mod_w + ((size_t)l * D + kg * 32) * 6144 + cb * 64 + 4 * cq;
            f32x4 a0 = {0.f, 0.f, 0.f, 0.f}, a1 = a0, a2 = a0;
#pragma unroll 8
            for (int kk = 0; kk < 32; ++kk) { const f32x4 wv = *(const f32x4*)(w + (size_t)kk * 6144); const int k = kg * 32 + kk;
                a0 += wv * sc[k]; a1 += wv * sc[D + k]; a2 += wv * sc[2 * D + k]; }
            *(LAS f32x4*)(red + (kg * 3 + 0) * 64 + 4 * cq) = a0; *(LAS f32x4*)(red + (kg * 3 + 1) * 64 + 4 * cq) = a1; *(LAS f32x4*)(red + (kg * 3 + 2) * 64 + 4 * cq) = a2;
            __syncthreads();
            if (tid < 192) { const int c = tid >> 6, col = tid & 63; float s = p.mod_b[l * 6144 + cb * 64 + col];
                for (int g2 = 0; g2 < 32; ++g2) s += red[(g2 * 3 + c) * 64 + col];
                ((float*)(p.ws + CTL_MOD))[(size_t)(l * 3 + c) * 6144 + cb * 64 + col] = s; }
            __syncthreads();
        }
    }
    const int gt = bid * 512 + tid, NT = G * 512;
    for (int i = gt; i < 2048; i += NT) ((float*)(p.ws + WS_LB))[i] = sigmoidf_(p.h_lb[2048 + i] - p.h_lb[i]);
    {
        bf16_t* tb = (bf16_t*)(p.ws + WS_TAB);
        for (int e = gt; e < 335872; e += NT) {
            int r = e; float v; bf16_t* dst;
            if (r < 8192) { const int m = r >> 6, k = r & 63; const int mm = m & 63; const float a = 2.f * (float)((mm * k) & 63) / 64.f;
                v = (m < 64 ? cospif(a) : -sinpif(a)) * 0.125f; dst = tb + TAB_T64 / 2 + r; }
            else if ((r -= 8192) < 32768) { const int m = r >> 7, k = r & 127; const int mm = m & 127; const float a = 2.f * (float)((mm * k) & 127) / 128.f;
                v = (m < 128 ? cospif(a) : -sinpif(a)) * 0.08838834764831845f; dst = tb + TAB_T128A / 2 + r; }
            else if ((r -= 32768) < 32768) { const int m = r >> 7, k = r & 127; const int mm = m & 127; const float a = 2.f * (float)((mm * k) & 127) / 128.f;
                v = (m < 128 ? sinpif(a) : cospif(a)) * 0.08838834764831845f; dst = tb + TAB_T128B / 2 + r; }
            else if ((r -= 32768) < 131072) { const int m = r >> 8, k = r & 255; const int mm = m & 255; const float a = 2.f * (float)((mm * k) & 255) / 256.f;
                v = (m < 256 ? cospif(a) : -sinpif(a)) * 0.0625f; dst = tb + TAB_T256 / 2 + r; }
            else if ((r -= 131072) < 65536) { const int m = r >> 8, k = r & 255; const float a = 2.f * (float)((m * k) & 255) / 256.f; v = cospif(a) * 0.0625f; dst = tb + TAB_C256 / 2 + r; }
            else { r -= 65536; const int m = r >> 8, k = r & 255; const float a = 2.f * (float)((m * k) & 255) / 256.f; v = sinpif(a) * 0.0625f; dst = tb + TAB_S256 / 2 + r; }
            *dst = (bf16_t)f2bf(v);
        }
    }
    { bf16_t* wb = (bf16_t*)(p.ws + WS_WINB);
      for (int e = gt; e < D * D / 4; e += NT) { const f32x4 v = ((const f32x4*)p.f_w_in)[e]; u32x2 o; o.x = pk2(v.x, v.y); o.y = pk2(v.z, v.w); ((u32x2*)wb)[e] = o; } }
    {
        LAS float* scr = (LAS float*)(lds + wave * 8704);
        const int gw = bid * 8 + wave, NGW = G * 8;
        constexpr int I_FO = 16 * 32;
        for (int it = gw; it < I_FO; it += NGW) transpose_item(p.f_w_out, D, D, (bf16_t*)(p.ws + WS_WOUTT), scr, it, lane);
        { CvtRegs r; for (int it = gw; it < 8 * 32; it += NGW) { cvt_issue(r, p.h_w_out, D, it, lane); cvt_finish(r, (unsigned char*)(p.ws + WS_WHOT), D, D, it, lane); } }
        { CvtRegs r; for (int it = gw; it < 8 * 160; it += NGW) { cvt_issue(r, p.h_w_in, NHI, it, lane); cvt_finish(r, (unsigned char*)(p.ws + WS_WHIT8), D, NHI, it, lane); } }
    }
}

struct RowsDense { const bf16_t* base; size_t ld; __device__ __forceinline__ const bf16_t* row(int i) const { return base + (size_t)i * ld; } };
__device__ __forceinline__ void st_bf4(bf16_t* p, f32x4 v) { u32x2 o; o.x = pk2(v.x, v.y); o.y = pk2(v.z, v.w); *(u32x2*)p = o; }

template <int KD, bool TWO> struct DftRegs { u32x4 v[(KD * 8 + 511) / 512][TWO ? 2 : 1]; };
template <int KD, bool TWO> __device__ __forceinline__ void dft_fetch(DftRegs<KD, TWO>& r, const bf16_t* x1, const bf16_t* x2, size_t xpitch) {
    const int tid = TIDX;
#pragma unroll
    for (int q = 0; q < (KD * 8 + 511) / 512; ++q) { const int e = tid + 512 * q; if (e < KD * 8) { const int k = e >> 3, c8 = (e & 7) * 8;
        r.v[q][0] = *(const u32x4*)(x1 + (size_t)k * xpitch + c8); if (TWO) r.v[q][TWO ? 1 : 0] = *(const u32x4*)(x2 + (size_t)k * xpitch + c8); } }
}
template <int KD, bool TWO> __device__ __forceinline__ void dft_stage(LAS unsigned char* lds, const DftRegs<KD, TWO>& r, unsigned flip2 = 0u) {
    constexpr int PITCH = KD + 8; LAS bf16_t* XT1 = (LAS bf16_t*)lds; LAS bf16_t* XT2 = XT1 + 64 * PITCH; const int tid = TIDX;
#pragma unroll
    for (int q = 0; q < (KD * 8 + 511) / 512; ++q) { const int e = tid + 512 * q; if (e < KD * 8) { const int k = e >> 3, c8 = (e & 7) * 8;
        const unsigned w[4] = {r.v[q][0].x, r.v[q][0].y, r.v[q][0].z, r.v[q][0].w};
#pragma unroll
        for (int j = 0; j < 4; ++j) { XT1[(c8 + 2 * j) * PITCH + k] = (bf16_t)(w[j] & 0xffffu); XT1[(c8 + 2 * j + 1) * PITCH + k] = (bf16_t)(w[j] >> 16); }
        if (TWO) { const unsigned w2[4] = {r.v[q][TWO ? 1 : 0].x ^ flip2, r.v[q][TWO ? 1 : 0].y ^ flip2, r.v[q][TWO ? 1 : 0].z ^ flip2, r.v[q][TWO ? 1 : 0].w ^ flip2};
#pragma unroll
            for (int j = 0; j < 4; ++j) { XT2[(c8 + 2 * j) * PITCH + k] = (bf16_t)(w2[j] & 0xffffu); XT2[(c8 + 2 * j + 1) * PITCH + k] = (bf16_t)(w2[j] >> 16); } } } }
}
template <int KD, bool TWO> struct DftT { bf16x8 t[(2 * KD) / 128][KD / 32][TWO ? 2 : 1]; };
template <int KD, bool TWO> __device__ __forceinline__ void dft_load_t(DftT<KD, TWO>& T, const bf16_t* T1, const bf16_t* T2) {
    constexpr int MT = (2 * KD) / 128; const int lane = TIDX & 63, wid = TIDX >> 6, fr = lane & 15, fq = lane >> 4; const int mrow0 = wid * (MT * 16);
#pragma unroll
    for (int mi = 0; mi < MT; ++mi)
#pragma unroll
        for (int ks = 0; ks < KD / 32; ++ks) { T.t[mi][ks][0] = *(const bf16x8*)(T1 + (size_t)(mrow0 + mi * 16 + fr) * KD + ks * 32 + fq * 8);
            if (TWO) T.t[mi][ks][TWO ? 1 : 0] = *(const bf16x8*)(T2 + (size_t)(mrow0 + mi * 16 + fr) * KD + ks * 32 + fq * 8); }
}
template <int KD, bool OUT8 = false> __device__ __forceinline__ void dft_compute_stream(LAS unsigned char* lds, const bf16_t* T1, bf16_t* obase, size_t opitch) {
    constexpr int PITCH = KD + 8, MT = (2 * KD) / 128; const LAS bf16_t* XT1 = (const LAS bf16_t*)lds;
    const int lane = TIDX & 63, wid = TIDX >> 6, fr = lane & 15, fq = lane >> 4; const int mrow0 = wid * (MT * 16);
    f32x4 acc[MT][4];
#pragma unroll
    for (int i = 0; i < MT; ++i)
#pragma unroll
        for (int j = 0; j < 4; ++j) acc[i][j] = (f32x4){0.f, 0.f, 0.f, 0.f};
#pragma unroll 2
    for (int ks = 0; ks < KD / 32; ++ks) { bf16x8 xb[4], ta[MT];
#pragma unroll
        for (int mi = 0; mi < MT; ++mi) ta[mi] = *(const bf16x8*)(T1 + (size_t)(mrow0 + mi * 16 + fr) * KD + ks * 32 + fq * 8);
#pragma unroll
        for (int ni = 0; ni < 4; ++ni) xb[ni] = *(const LAS bf16x8*)(XT1 + (ni * 16 + fr) * PITCH + ks * 32 + fq * 8);
#pragma unroll
        for (int mi = 0; mi < MT; ++mi)
#pragma unroll
            for (int ni = 0; ni < 4; ++ni) acc[mi][ni] = __builtin_amdgcn_mfma_f32_16x16x32_bf16(xb[ni], ta[mi], acc[mi][ni], 0, 0, 0); }
#pragma unroll
    for (int mi = 0; mi < MT; ++mi) { const int m = mrow0 + mi * 16 + fr;
        if constexpr (OUT8) { unsigned w[4];
#pragma unroll
            for (int ni = 0; ni < 4; ++ni) { f32x4 v = acc[mi][ni];
#pragma unroll
                for (int j = 0; j < 4; ++j) v[j] = __builtin_amdgcn_fmed3f(v[j], -448.f, 448.f);
                w[ni] = pk4_fp8(v[0], v[1], v[2], v[3]); }
            const auto s01 = __builtin_amdgcn_permlane16_swap(w[0], w[1], false, false), s23 = __builtin_amdgcn_permlane16_swap(w[2], w[3], false, false);
            const auto t02 = __builtin_amdgcn_permlane32_swap(s01[0], s23[0], false, false), t13 = __builtin_amdgcn_permlane32_swap(s01[1], s23[1], false, false);
            unsigned char* orow8 = (unsigned char*)obase + (size_t)(m % KD) * opitch + (m >= KD ? D : 0);
            *(u32x4*)(orow8 + 16 * fq) = (u32x4){t02[0], t13[0], t02[1], t13[1]};
        } else { bf16_t* orow = obase + (size_t)(m % KD) * opitch + (m >= KD ? D : 0);
#pragma unroll
            for (int ni = 0; ni < 4; ++ni) st_bf4(orow + ni * 16 + 4 * fq, acc[mi][ni]); } }
}
template <int KD, bool TWO, bool OUT8 = false> __device__ __forceinline__ void dft_compute(LAS unsigned char* lds, const DftT<KD, TWO>& T, bf16_t* obase, size_t opitch) {
    constexpr int PITCH = KD + 8, MT = (2 * KD) / 128; const LAS bf16_t* XT1 = (const LAS bf16_t*)lds; const LAS bf16_t* XT2 = XT1 + 64 * PITCH;
    const int lane = TIDX & 63, wid = TIDX >> 6, fr = lane & 15, fq = lane >> 4; const int mrow0 = wid * (MT * 16);
    f32x4 acc[MT][4];
#pragma unroll
    for (int i = 0; i < MT; ++i)
#pragma unroll
        for (int j = 0; j < 4; ++j) acc[i][j] = (f32x4){0.f, 0.f, 0.f, 0.f};
#pragma unroll
    for (int ks = 0; ks < KD / 32; ++ks) { bf16x8 xb[4];
#pragma unroll
        for (int ni = 0; ni < 4; ++ni) xb[ni] = *(const LAS bf16x8*)(XT1 + (ni * 16 + fr) * PITCH + ks * 32 + fq * 8);
#pragma unroll
        for (int mi = 0; mi < MT; ++mi)
#pragma unroll
            for (int ni = 0; ni < 4; ++ni) acc[mi][ni] = __builtin_amdgcn_mfma_f32_16x16x32_bf16(xb[ni], T.t[mi][ks][0], acc[mi][ni], 0, 0, 0);
        if (TWO) {
#pragma unroll
            for (int ni = 0; ni < 4; ++ni) xb[ni] = *(const LAS bf16x8*)(XT2 + (ni * 16 + fr) * PITCH + ks * 32 + fq * 8);
#pragma unroll
            for (int mi = 0; mi < MT; ++mi)
#pragma unroll
                for (int ni = 0; ni < 4; ++ni) acc[mi][ni] = __builtin_amdgcn_mfma_f32_16x16x32_bf16(xb[ni], T.t[mi][ks][TWO ? 1 : 0], acc[mi][ni], 0, 0, 0); } }
#pragma unroll
    for (int mi = 0; mi < MT; ++mi) { const int m = mrow0 + mi * 16 + fr;
        if constexpr (OUT8) {
            unsigned w[4];
#pragma unroll
            for (int ni = 0; ni < 4; ++ni) { f32x4 v = acc[mi][ni];
#pragma unroll
                for (int j = 0; j < 4; ++j) v[j] = __builtin_amdgcn_fmed3f(v[j], -448.f, 448.f);
                w[ni] = pk4_fp8(v[0], v[1], v[2], v[3]); }
            const auto s01 = __builtin_amdgcn_permlane16_swap(w[0], w[1], false, false), s23 = __builtin_amdgcn_permlane16_swap(w[2], w[3], false, false);
            const auto t02 = __builtin_amdgcn_permlane32_swap(s01[0], s23[0], false, false), t13 = __builtin_amdgcn_permlane32_swap(s01[1], s23[1], false, false);
            unsigned char* orow8 = (unsigned char*)obase + (size_t)(m % KD) * opitch + (m >= KD ? D : 0);
            *(u32x4*)(orow8 + 16 * fq) = (u32x4){t02[0], t13[0], t02[1], t13[1]};
        } else { bf16_t* orow = obase + (size_t)(m % KD) * opitch + (m >= KD ? D : 0);
#pragma unroll
            for (int ni = 0; ni < 4; ++ni) st_bf4(orow + ni * 16 + 4 * fq, acc[mi][ni]); } }
}

struct RowVec { f32x4 v[4]; };
__device__ __forceinline__ RowVec ld_row_f32(const float* r, int lane) { RowVec o;
#pragma unroll
    for (int j = 0; j < 4; ++j) o.v[j] = *(const f32x4*)(r + 256 * j + 4 * lane);
    return o; }
__device__ __forceinline__ RowVec ld_row_bf16(const bf16_t* r, int lane) { RowVec o;
#pragma unroll
    for (int j = 0; j < 4; ++j) { const u32x2 w = *(const u32x2*)(r + 256 * j + 4 * lane); o.v[j] = (f32x4){bf2f(w.x & 0xffffu), bf2f(w.x >> 16), bf2f(w.y & 0xffffu), bf2f(w.y >> 16)}; }
    return o; }
__device__ __forceinline__ void st_row_f32(float* r, int lane, const RowVec& o) {
#pragma unroll
    for (int j = 0; j < 4; ++j) *(f32x4*)(r + 256 * j + 4 * lane) = o.v[j]; }
__device__ __forceinline__ void st_row_bf16(bf16_t* r, int lane, const RowVec& o) {
#pragma unroll
    for (int j = 0; j < 4; ++j) st_bf4(r + 256 * j + 4 * lane, o.v[j]); }
__device__ __forceinline__ float row_rs(const RowVec& x) { float s = 0.f;
#pragma unroll
    for (int j = 0; j < 4; ++j) s += (x.v[j].x * x.v[j].x + x.v[j].y * x.v[j].y) + (x.v[j].z * x.v[j].z + x.v[j].w * x.v[j].w);
    return rsqrtf(wave_sum(s) * (1.f / D) + EPS); }
__device__ __forceinline__ void ld_modvec(const P& p, const float* g, int l, int cond, int sub, int lane, RowVec& a, RowVec& s) {
    const RowVec gv = ld_row_f32(g, lane), sc = ld_row_f32(modp(p, l, cond, sub * 3 + 1), lane); s = ld_row_f32(modp(p, l, cond, sub * 3), lane);
#pragma unroll
    for (int j = 0; j < 4; ++j) a.v[j] = gv.v[j] * (sc.v[j] + 1.f); }
__device__ __forceinline__ void seg_range(int s, int& r0, int& n, int& cond) { if (s == 0) { r0 = 0; n = NCTX; cond = 2; } else { r0 = NCTX + (s - 1) * SEQ; n = SEQ; cond = s - 1; } }


__device__ __forceinline__ void ph_mod2_route(const P& p, int l, LAS unsigned char* lds) {
    const int tid = TIDX, lane = tid & 63, wave = __builtin_amdgcn_readfirstlane(tid >> 6), fr = lane & 15, fq = lane >> 4;
    LAS float* wl = (LAS float*)lds;
    LAS float* av = (LAS float*)(lds + 131072);
    LAS float* sv = av + 3 * D;
    LAS int* lcnt = (LAS int*)(lds + 155648);
    LAS int* rec = lcnt + 64;
    __syncthreads();
    { const f32x4* src = (const f32x4*)(p.router_w + (size_t)l * D * NE);
      const int rot = (blockIdx.x >> 3) + (blockIdx.x & 7) * 2;
      for (int i = 0; i < 16; ++i) { const int e = (((i + rot) & 15) << 9) + tid; const int k = e >> 3, e0 = (e & 7) * 4; const f32x4 w = src[e];
          const int t = k >> 6, kq = (k >> 4) & 3, c = k & 15, q = c >> 2, r = c & 3;
#pragma unroll
          for (int i = 0; i < 4; ++i) { const int ex = e0 + i; wl[((((t * 2 + (ex >> 4)) * 4 + q) * 64 + kq * 16 + (ex & 15)) << 2) + r] = w[i]; } } }
    for (int e = tid; e < 3 * D; e += 512) { const int cond = e >> 10, k = e & 1023; av[e] = p.norm2_g[l * D + k] * (1.f + modp(p, l, cond, 4)[k]); sv[e] = modp(p, l, cond, 3)[k]; }
    if (tid < 32) lcnt[tid] = 0;
    __syncthreads();
    const bool ctxwg = (l == 0 && blockIdx.x < NCTX / 16);
    const bool rowwave = wave < 4 || (wave == 4 && ctxwg);
    if (rowwave) {
        unsigned char* Hb8 = (unsigned char*)(p.ws + WS_HB8); const bf16_t* X1 = (const bf16_t*)(p.ws + WS_X1);
        const int row0 = (wave == 4) ? (int)blockIdx.x * 16 : NCTX + (int)blockIdx.x * 64 + wave * 16;
        const int cond = (wave == 4) ? 2 : (int)((blockIdx.x * 64 + wave * 16) >> 13);
        const int row = row0 + fr;
        const bf16_t* xr = X1 + (size_t)row * D + 16 * fq;
        float rs; u32x4 ring[4][2];
        { float ss = 0.f;
#pragma unroll
          for (int t = 0; t < 16; ++t) { const u32x4 r0 = *(const u32x4*)(xr + 64 * t), r1 = *(const u32x4*)(xr + 64 * t + 8);
              if (t < 4) { ring[t][0] = r0; ring[t][1] = r1; }
#pragma unroll
              for (int j = 0; j < 4; ++j) { const float a0 = bf2f(r0[j] & 0xffffu), a1 = __uint_as_float(r0[j] & 0xffff0000u), b0 = bf2f(r1[j] & 0xffffu), b1 = __uint_as_float(r1[j] & 0xffff0000u);
                  ss += (a0 * a0 + a1 * a1) + (b0 * b0 + b1 * b1); } }
          ss += __shfl_xor(ss, 16); ss += __shfl_xor(ss, 32);
          rs = rsqrtf(ss * (1.f / D) + EPS); }
        f32x4 acc0 = {0.f, 0.f, 0.f, 0.f}, acc1 = {0.f, 0.f, 0.f, 0.f};
        { const LAS float* ap = av + cond * D + 16 * fq; const LAS float* sp = sv + cond * D + 16 * fq; unsigned char* hp = Hb8 + (size_t)row * D + 16 * fq;
          const LAS float* wp = wl + (lane << 2);
#pragma unroll 1
          for (int t0 = 0; t0 < 16; t0 += 4) {
#pragma unroll
          for (int ts = 0; ts < 4; ++ts) { const int t = t0 + ts; const u32x4 r0 = ring[ts][0], r1 = ring[ts][1];
              if (t0 < 12) { ring[ts][0] = *(const u32x4*)(xr + 64 * (t + 4)); ring[ts][1] = *(const u32x4*)(xr + 64 * (t + 4) + 8); }
              f32x4 h[4];
              const unsigned xw[8] = {r0[0], r0[1], r0[2], r0[3], r1[0], r1[1], r1[2], r1[3]};
#pragma unroll
              for (int q = 0; q < 4; ++q) { const f32x4 a4 = *(const LAS f32x4*)(ap + 64 * t + 4 * q), s4 = *(const LAS f32x4*)(sp + 64 * t + 4 * q);
                  const unsigned w0 = xw[2 * q], w1 = xw[2 * q + 1];
                  const f32x4 x4 = {bf2f(w0 & 0xffffu), __uint_as_float(w0 & 0xffff0000u), bf2f(w1 & 0xffffu), __uint_as_float(w1 & 0xffff0000u)};
                  h[q] = x4 * rs * a4 + s4; }
              *(u32x4*)(hp + 64 * t) = (u32x4){pk4_fp8(h[0][0], h[0][1], h[0][2], h[0][3]), pk4_fp8(h[1][0], h[1][1], h[1][2], h[1][3]), pk4_fp8(h[2][0], h[2][1], h[2][2], h[2][3]), pk4_fp8(h[3][0], h[3][1], h[3][2], h[3][3])};
#pragma unroll
              for (int q = 0; q < 4; ++q) { const f32x4 wa = *(const LAS f32x4*)(wp + ((t * 2 + 0) * 4 + q) * 256), wb = *(const LAS f32x4*)(wp + ((t * 2 + 1) * 4 + q) * 256);
#pragma unroll
                  for (int r = 0; r < 4; ++r) { acc0 = __builtin_amdgcn_mfma_f32_16x16x4f32(wa[r], h[q][r], acc0, 0, 0, 0); acc1 = __builtin_amdgcn_mfma_f32_16x16x4f32(wb[r], h[q][r], acc1, 0, 0, 0); } }
          } } }
        {
          const f32x4 b0 = *(const f32x4*)(p.router_b + l * NE + 4 * fq), b1 = *(const f32x4*)(p.router_b + l * NE + 16 + 4 * fq);
          float v[8];
#pragma unroll
          for (int r = 0; r < 4; ++r) { v[r] = acc0[r] + b0[r]; v[4 + r] = acc1[r] + b1[r]; }
          float tv[4]; int te[4];
#pragma unroll
          for (int k = 0; k < 4; ++k) { float bv = v[0]; int bc = 0;
#pragma unroll
              for (int ci = 1; ci < 8; ++ci) if (v[ci] > bv) { bv = v[ci]; bc = ci; }
              int bi = ((bc >> 2) << 4) + 4 * fq + (bc & 3);
#pragma unroll
              for (int o = 16; o < 64; o <<= 1) { const float ov = __shfl_xor(bv, o); const int oi = __shfl_xor(bi, o); if (ov > bv || (ov == bv && oi < bi)) { bv = ov; bi = oi; } }
              tv[k] = bv; te[k] = bi;
#pragma unroll
              for (int ci = 0; ci < 8; ++ci) if (((ci >> 2) << 4) + 4 * fq + (ci & 3) == bi) v[ci] = -3.0e38f; }
          const float e1 = __expf(tv[1] - tv[0]), e2 = __expf(tv[2] - tv[0]), e3 = __expf(tv[3] - tv[0]); const float inv = 1.f / (1.f + e1 + e2 + e3);
          { const int ek = fq == 0 ? te[0] : fq == 1 ? te[1] : fq == 2 ? te[2] : te[3];
            const float gk = (fq == 0 ? 1.f : fq == 1 ? e1 : fq == 2 ? e2 : e3) * inv;
            const int lp = __hip_atomic_fetch_add(lcnt + ek, 1, __ATOMIC_RELAXED, __HIP_MEMORY_SCOPE_WORKGROUP);
            LAS int* rc = rec + ((wave * 16 + fr) * 4 + fq) * 4; rc[0] = row; rc[1] = ek; rc[2] = lp; rc[3] = __float_as_int(gk); } }
    } else {
        const int nb = ctxwg ? 3 : 4, bi = wave - (ctxwg ? 5 : 4);
        constexpr int RS0 = 7, RNI = (12 - RS0) * 8;
        CvtRegs ca, cb;
        auto item = [&](int j) { return bg_item(l, (RS0 + (j >> 3)) * 2048 + (int)blockIdx.x * 8 + (j & 7)); };
        int j = bi; if (j < RNI) cvt_item_issue(ca, p, item(j), lane);
#pragma unroll 1
        for (; j < RNI; j += 2 * nb) { const bool two = j + nb < RNI; if (two) cvt_item_issue(cb, p, item(j + nb), lane);
            cvt_item_finish(ca, p, item(j), lane);
            if (j + 2 * nb < RNI) cvt_item_issue(ca, p, item(j + 2 * nb), lane);
            if (two) cvt_item_finish(cb, p, item(j + nb), lane); }
    }
    __syncthreads();
    int* cnt = (int*)(p.ws + CTL_CNT) + l * NE * CNT_STRIDE; int* list = (int*)(p.ws + WS_ROUTE + RT_LIST);
    int* asg_e = (int*)(p.ws + WS_ROUTE + RT_ASGE); int* asg_p = (int*)(p.ws + WS_ROUTE + RT_ASGP); float* gate = (float*)(p.ws + WS_ROUTE + RT_GATE);
    const int tokbase = (l == 0) ? 0 : NCTX;
    const int tid2 = TIDX, lane2 = tid2 & 63, wave2 = tid2 >> 6;
    if (tid2 < 32) { const int c = lcnt[tid2]; lcnt[tid2] = c ? atomicAdd(cnt + tid2 * CNT_STRIDE, c) : 0; }
    __syncthreads();
    if (wave2 < 4 || (wave2 == 4 && l == 0 && blockIdx.x < NCTX / 16)) {
        const LAS int* rc = rec + (wave2 * 64 + lane2) * 4; const int row = rc[0], ek = rc[1], pos = lcnt[ek] + rc[2]; const int tokm = row - tokbase, k = lane2 & 3;
        list[(size_t)ek * NTOK + pos] = row; asg_e[tokm * 4 + k] = ek; asg_p[tokm * 4 + k] = pos; gate[tokm * 4 + k] = __int_as_float(rc[3]); }
}

__device__ __forceinline__ void ph_combine(const P& p, int l) {
    const int tid = TIDX, lane = tid & 63, gw = blockIdx.x * 8 + (tid >> 6), NGW = gridDim.x * 8;
    const int* cnt = (const int*)(p.ws + CTL_CNT) + l * NE * CNT_STRIDE;
    int ps; { const int c = cnt[(lane & 31) * CNT_STRIDE]; const int pc = (c + 255) & ~255; int incl = pc;
#pragma unroll
        for (int o = 1; o < 32; o <<= 1) { const int t = __shfl_up(incl, o); if ((lane & 31) >= o) incl += t; }
        ps = incl - pc; }
    typedef int i32x4v __attribute__((ext_vector_type(4)));
    const i32x4v* asg_e = (const i32x4v*)(p.ws + WS_ROUTE + RT_ASGE); const i32x4v* asg_p = (const i32x4v*)(p.ws + WS_ROUTE + RT_ASGP); const f32x4* gate = (const f32x4*)(p.ws + WS_ROUTE + RT_GATE);
    const bf16_t* Yb = (const bf16_t*)(p.ws + WS_YB); const bf16_t* X1 = (const bf16_t*)(p.ws + WS_X1); bf16_t* X2 = (bf16_t*)(p.ws + WS_X2); bf16_t* Hb = (bf16_t*)(p.ws + WS_HB);
    const int tokbase = (l == 0) ? 0 : NCTX;
    for (int s = (l == 0 ? 0 : 1); s < 3; ++s) { int r0, n, cond; seg_range(s, r0, n, cond);
        const RowVec g2 = ld_row_f32(modp(p, l, cond, 5), lane); RowVec a, sh;
        if (l == 0) ld_modvec(p, p.norm1_g + D, 1, cond, 0, lane, a, sh); else { a = ld_row_f32(p.final_g, lane); sh = a; }
        i32x4v eA = {0, 0, 0, 0}, pA = eA; f32x4 gA = {0.f, 0.f, 0.f, 0.f}; RowVec xA; f32x4 gB = gA; RowVec xB; unsigned yB[4][4];
#define CMB_LOAD_A(rr) do { const int tokm_ = r0 + (rr) - tokbase; eA = asg_e[tokm_]; pA = asg_p[tokm_]; gA = gate[tokm_]; xA = ld_row_bf16(X1 + (size_t)(r0 + (rr)) * D, lane); } while (0)
#define CMB_LOAD_B() do { _Pragma("unroll") for (int k = 0; k < 4; ++k) { const int prow_ = __shfl(ps, eA[k]) + pA[k]; const unsigned char* yr_ = (const unsigned char*)Yb + (size_t)prow_ * D; \
            _Pragma("unroll") for (int j = 0; j < 4; ++j) yB[k][j] = __builtin_nontemporal_load((const unsigned*)(yr_ + 256 * j + 4 * lane)); } gB = gA; xB = xA; } while (0)
        if (gw < n) { CMB_LOAD_A(gw); CMB_LOAD_B(); if (gw + NGW < n) CMB_LOAD_A(gw + NGW); }
        for (int r = gw; r < n; r += NGW) { const int row = r0 + r;
            RowVec y;
#pragma unroll
            for (int j = 0; j < 4; ++j) y.v[j] = (f32x4){0.f, 0.f, 0.f, 0.f};
#pragma unroll
            for (int k = 0; k < 4; ++k) { const float gk = gB[k] * (1.f / YB_SCALE);
#pragma unroll
                for (int j = 0; j < 4; ++j) { const unsigned w = yB[k][j];
                    y.v[j].x += gk * __builtin_amdgcn_cvt_f32_fp8(w, 0); y.v[j].y += gk * __builtin_amdgcn_cvt_f32_fp8(w, 1); y.v[j].z += gk * __builtin_amdgcn_cvt_f32_fp8(w, 2); y.v[j].w += gk * __builtin_amdgcn_cvt_f32_fp8(w, 3); } }
            RowVec x = xB;
            if (r + NGW < n) { CMB_LOAD_B(); if (r + 2 * NGW < n) CMB_LOAD_A(r + 2 * NGW); }
#pragma unroll
            for (int j = 0; j < 4; ++j) x.v[j] = x.v[j] + g2.v[j] * y.v[j];
            const float rs = row_rs(x);
            if (l == 0) { st_row_bf16(X2 + (size_t)row * D, lane, x);
#pragma unroll
                for (int j = 0; j < 4; ++j) x.v[j] = x.v[j] * rs * a.v[j] + sh.v[j];
                {
#pragma unroll
                    for (int j = 0; j < 4; ++j) *(unsigned*)((unsigned char*)(p.ws + WS_HBH8) + (size_t)row * D + 256 * j + 4 * lane) = pk4_fp8(x.v[j].x, x.v[j].y, x.v[j].z, x.v[j].w); } }
            else {
#pragma unroll
                for (int j = 0; j < 4; ++j) x.v[j] = x.v[j] * rs * a.v[j];
                st_row_f32(p.out + (size_t)(row - NCTX) * D, lane, x); }
        }
#undef CMB_LOAD_A
#undef CMB_LOAD_B
    }
}

namespace pg8 {
constexpr int BM = 256, BK = 64, HALF = 128, HTB = HALF * BK * 2, STAGE_BYTES = 8 * HTB;
__device__ __forceinline__ int lds_byte(int r, int c) { const int st = (r >> 4) * 2 + (c >> 5), rr = r & 15, cc = c & 31, ob = rr * 64 + cc * 2; return st * 1024 + (ob ^ (((ob >> 9) & 1) << 5)); }
__device__ __forceinline__ void stage_rc(int b, int& R, int& C) { const int st = b / 1024, sb = b % 1024, swz = sb ^ (((sb >> 9) & 1) << 5); R = (st >> 1) * 16 + swz / 64; C = (st & 1) * 32 + (swz % 64) / 2; }
__device__ __forceinline__ int perm32(int rho) { const int n = rho >> 4, i = rho & 15; return 8 * (i >> 2) + 4 * n + (i & 3); }
struct GUnit { const char* a; const char* b0; const char* b1; int e0, e1, e2, e3; };
__device__ __forceinline__ unsigned cvt_pk_bf16(float lo, float hi) { unsigned r; asm volatile("v_cvt_pk_bf16_f32 %0, %1, %2" : "=v"(r) : "v"(lo), "v"(hi)); return r; }

typedef int i32x4 __attribute__((ext_vector_type(4)));
typedef int i32x8 __attribute__((ext_vector_type(8)));
__device__ __forceinline__ i32x8 cat8(bf16x8 lo, bf16x8 hi) { return __builtin_shufflevector(__builtin_bit_cast(i32x4, lo), __builtin_bit_cast(i32x4, hi), 0, 1, 2, 3, 4, 5, 6, 7); }
template <class Epi, class Sched, bool FP8 = false, bool ALIGN_EPI = true, bool SP2 = true>
__device__ __forceinline__ void gemm_phase(LAS unsigned char* lds, const int RB, const Sched& S, const Epi& E) {
    const int tid = TIDX, wid = __builtin_amdgcn_readfirstlane(tid >> 6), lane = tid & 63, wr = wid >> 2, wc = wid & 3, fr = lane & 15, fq = lane >> 4;
    const int nt = RB / 128;
    int Rr[2], Cc[2]; unsigned voffB[2];
#pragma unroll
    for (int i = 0; i < 2; ++i) { stage_rc(tid * 16 + i * 8192, Rr[i], Cc[i]); const int Rb = Epi::PERM ? ((Rr[i] & ~31) + perm32(Rr[i] & 31)) : Rr[i]; voffB[i] = (unsigned)(Rb * RB + Cc[i] * 2); }
    const size_t kstep = (size_t)(BK * 2);
    const unsigned ldsw = (unsigned)wid * 1024u;
    const int aoff = lds_byte(wr * 64 + fr, fq * 8), boff = lds_byte(wc * 32 + fr, fq * 8);
#define PG8_SA(b, h) (((b) * 2 + (h)) * HTB)
#define PG8_SB(b, h) ((4 + (b) * 2 + (h)) * HTB)
#define PG8_STAGE(bufoff, gbase, voff) do { _Pragma("unroll") for (int _i = 0; _i < 2; ++_i) \
        __builtin_amdgcn_global_load_lds((const unsigned*)((const char*)(gbase) + (voff)[_i]), (LAS unsigned*)(lds + (bufoff) + ldsw + _i * 8192), 16, 0, 0); } while (0)
#define PG8_LDA(dst, b, h) do { _Pragma("unroll") for (int m = 0; m < 4; ++m) { const bf16x8 _l = *(const LAS bf16x8*)(lds + PG8_SA(b, h) + aoff + m * 2048), _h = *(const LAS bf16x8*)(lds + PG8_SA(b, h) + aoff + m * 2048 + 1024); \
        if constexpr (FP8) dst##8[m] = cat8(_l, _h); else { dst[m][0] = _l; dst[m][1] = _h; } } } while (0)
#define PG8_LDB(dst, b, h) do { _Pragma("unroll") for (int n = 0; n < 2; ++n) { const bf16x8 _l = *(const LAS bf16x8*)(lds + PG8_SB(b, h) + boff + n * 2048), _h = *(const LAS bf16x8*)(lds + PG8_SB(b, h) + boff + n * 2048 + 1024); \
        if constexpr (FP8) dst##8[n] = cat8(_l, _h); else { dst[n][0] = _l; dst[n][1] = _h; } } } while (0)
#define PG8_MMA(ai, bj, At, Bt) do { __builtin_amdgcn_s_setprio(1); \
        if constexpr (FP8) { _Pragma("unroll") for (int m = 0; m < 4; ++m) _Pragma("unroll") for (int n = 0; n < 2; ++n) \
            asm volatile("v_mfma_scale_f32_16x16x128_f8f6f4 %0, %1, %2, %0, %3, %3 op_sel_hi:[0,0,0]" : "+v"(acc[ai][bj][m][n]) : "v"(Bt##8[n]), "v"(At##8[m]), "v"(mx_one)); } \
        else { _Pragma("unroll") for (int m = 0; m < 4; ++m) _Pragma("unroll") for (int n = 0; n < 2; ++n) _Pragma("unroll") for (int k = 0; k < 2; ++k) \
            acc[ai][bj][m][n] = __builtin_amdgcn_mfma_f32_16x16x32_bf16(Bt[n][k], At[m][k], acc[ai][bj][m][n], 0, 0, 0); } \
        __builtin_amdgcn_s_setprio(0); } while (0)
#define PG8_WAIT_V(n) asm volatile("s_waitcnt vmcnt(" #n ")" ::: "memory")
#define PG8_WAIT_L(n) asm volatile("s_waitcnt lgkmcnt(" #n ")" ::: "memory")
#define PG8_BAR __builtin_amdgcn_s_barrier()
#define PG8_SCHED __builtin_amdgcn_sched_barrier(0)
    const unsigned mx_one = 0x7f7f7f7fu;
    GUnit cur, nxt; int ui = 0;
    if (!S.next(0, cur)) return;
    f32x4 acc[2][2][4][2];
#pragma unroll
    for (int a = 0; a < 2; ++a)
#pragma unroll
        for (int b = 0; b < 2; ++b)
#pragma unroll
            for (int m = 0; m < 4; ++m)
#pragma unroll
                for (int n = 0; n < 2; ++n) acc[a][b][m][n] = (f32x4){0.f, 0.f, 0.f, 0.f};
    bf16x8 At[4][2], B0[2][2], B1[2][2]; i32x8 At8[4], B08[2], B18[2];
    unsigned cA0[2], cA1[2];
#pragma unroll
    for (int i = 0; i < 2; ++i) { cA0[i] = S.a_off(0, cur, Rr[i]) + (unsigned)Cc[i] * 2u; cA1[i] = S.a_off(0, cur, HALF + Rr[i]) + (unsigned)Cc[i] * 2u; }
    const char* cA = cur.a; const char* cB0 = cur.b0; const char* cB1 = cur.b1;
    if constexpr (SP2) {
        PG8_STAGE(PG8_SB(0, 0), cB0, voffB); PG8_STAGE(PG8_SB(0, 1), cB1, voffB); PG8_STAGE(PG8_SA(0, 0), cA, cA0); PG8_STAGE(PG8_SA(0, 1), cA, cA1);
        if (wr == 1) PG8_BAR;
        PG8_WAIT_V(2); PG8_BAR;
        PG8_STAGE(PG8_SB(1, 0), cB0 + kstep, voffB); PG8_STAGE(PG8_SA(1, 0), cA + kstep, cA0); PG8_STAGE(PG8_SB(1, 1), cB1 + kstep, voffB);
        PG8_WAIT_V(6); PG8_BAR;
    } else {
        PG8_STAGE(PG8_SB(0, 0), cB0, voffB); PG8_STAGE(PG8_SA(0, 0), cA, cA0); PG8_STAGE(PG8_SB(0, 1), cB1, voffB); PG8_STAGE(PG8_SA(0, 1), cA, cA1);
        if (wr == 1) PG8_BAR;
        PG8_WAIT_V(4); PG8_BAR;
        PG8_STAGE(PG8_SB(1, 0), cB0 + kstep, voffB); PG8_STAGE(PG8_SA(1, 0), cA + kstep, cA0); PG8_STAGE(PG8_SB(1, 1), cB1 + kstep, voffB);
        PG8_WAIT_V(6); PG8_BAR;
    }
    for (;;) {
        const bool has_next = S.next(ui + 1, nxt);
        const char* nA = has_next ? nxt.a : cA; const char* nB0 = has_next ? nxt.b0 : cB0; const char* nB1 = has_next ? nxt.b1 : cB1;
#pragma unroll 1
        for (int t = 0; t < nt; t += 2) {
            const bool last = (t == nt - 2);
            const char* a1 = cA + (size_t)(t + 1) * kstep;
            const char* a2 = last ? nA : cA + (size_t)(t + 2) * kstep; const char* b20 = last ? nB0 : cB0 + (size_t)(t + 2) * kstep; const char* b21 = last ? nB1 : cB1 + (size_t)(t + 2) * kstep;
            const char* a3 = a2 + kstep; const char* b30 = b20 + kstep; const char* b31 = b21 + kstep;
            unsigned xA0[2], xA1[2];
#pragma unroll
            for (int i = 0; i < 2; ++i) { xA0[i] = cA0[i]; xA1[i] = cA1[i]; }
            if (last && has_next) { int tz = threadIdx.x; asm volatile("" : "+v"(tz));
#pragma unroll
                for (int i = 0; i < 2; ++i) { int R_, C_; stage_rc(tz * 16 + i * 8192, R_, C_); xA0[i] = S.a_off(ui + 1, nxt, R_) + (unsigned)C_ * 2u; xA1[i] = S.a_off(ui + 1, nxt, HALF + R_) + (unsigned)C_ * 2u; } }
            if constexpr (SP2) {
            const bool relax = (t == 0) && (ui > 0) && (Epi::VM_OPS > 0);
            PG8_LDB(B0, 0, 0); PG8_LDB(B1, 0, 1); PG8_SCHED; PG8_LDA(At, 0, 0); PG8_STAGE(PG8_SA(1, 1), a1, cA1);
            if (relax) { if constexpr (Epi::VM_OPS == 4) PG8_WAIT_V(12); else if constexpr (Epi::VM_OPS == 8) PG8_WAIT_V(16); else if constexpr (Epi::VM_OPS == 16) PG8_WAIT_V(24); else if constexpr (Epi::VM_OPS == 32) PG8_WAIT_V(40); else PG8_WAIT_V(8); } else PG8_WAIT_V(8);
            PG8_WAIT_L(0); PG8_BAR; PG8_MMA(0, 0, At, B0); PG8_MMA(0, 1, At, B1); PG8_BAR; PG8_SCHED;
            PG8_LDA(At, 0, 1); PG8_STAGE(PG8_SB(0, 0), b20, voffB); PG8_STAGE(PG8_SB(0, 1), b21, voffB); PG8_STAGE(PG8_SA(0, 0), a2, xA0);
            if (relax) { if constexpr (Epi::VM_OPS == 4) PG8_WAIT_V(12); else if constexpr (Epi::VM_OPS == 8) PG8_WAIT_V(16); else if constexpr (Epi::VM_OPS == 16) PG8_WAIT_V(24); else if constexpr (Epi::VM_OPS == 32) PG8_WAIT_V(40); else PG8_WAIT_V(8); } else PG8_WAIT_V(8);
            PG8_WAIT_L(0); PG8_BAR; PG8_MMA(1, 0, At, B0); PG8_MMA(1, 1, At, B1); PG8_BAR; PG8_SCHED;
            PG8_LDB(B0, 1, 0); PG8_LDB(B1, 1, 1); PG8_SCHED; PG8_LDA(At, 1, 0); PG8_STAGE(PG8_SA(0, 1), a2, xA1);
            PG8_WAIT_V(8); PG8_WAIT_L(0); PG8_BAR; PG8_MMA(0, 0, At, B0); PG8_MMA(0, 1, At, B1); PG8_BAR; PG8_SCHED;
            PG8_LDA(At, 1, 1); PG8_STAGE(PG8_SB(1, 0), b30, voffB); PG8_STAGE(PG8_SB(1, 1), b31, voffB); PG8_STAGE(PG8_SA(1, 0), a3, xA0);
            PG8_WAIT_V(8); PG8_WAIT_L(0); PG8_BAR; PG8_MMA(1, 0, At, B0); PG8_MMA(1, 1, At, B1); PG8_BAR; PG8_SCHED;
            } else {
            PG8_LDB(B0, 0, 0); PG8_SCHED; PG8_LDA(At, 0, 0); PG8_STAGE(PG8_SA(1, 1), a1, cA1);
            PG8_WAIT_L(8); PG8_BAR; PG8_WAIT_L(0); PG8_MMA(0, 0, At, B0); PG8_BAR; PG8_SCHED;
            PG8_LDB(B1, 0, 1); PG8_STAGE(PG8_SB(0, 0), b20, voffB);
            PG8_BAR; PG8_WAIT_L(0); PG8_MMA(0, 1, At, B1); PG8_BAR;
            PG8_LDA(At, 0, 1); PG8_STAGE(PG8_SA(0, 0), a2, xA0);
            PG8_BAR; PG8_WAIT_L(0); PG8_MMA(1, 0, At, B0); PG8_BAR; PG8_SCHED;
            PG8_STAGE(PG8_SB(0, 1), b21, voffB);
            PG8_WAIT_V(6); PG8_BAR; PG8_MMA(1, 1, At, B1); PG8_BAR;
            PG8_LDB(B0, 1, 0); PG8_SCHED; PG8_LDA(At, 1, 0); PG8_STAGE(PG8_SA(0, 1), a2, xA1);
            PG8_WAIT_L(8); PG8_BAR; PG8_WAIT_L(0); PG8_MMA(0, 0, At, B0); PG8_BAR; PG8_SCHED;
            PG8_LDB(B1, 1, 1); PG8_STAGE(PG8_SB(1, 0), b30, voffB);
            PG8_BAR; PG8_WAIT_L(0); PG8_MMA(0, 1, At, B1); PG8_BAR;
            PG8_LDA(At, 1, 1); PG8_STAGE(PG8_SA(1, 0), a3, xA0);
            PG8_BAR; PG8_WAIT_L(0); PG8_MMA(1, 0, At, B0); PG8_BAR; PG8_SCHED;
            PG8_STAGE(PG8_SB(1, 1), b31, voffB);
            PG8_WAIT_V(6); PG8_BAR; PG8_MMA(1, 1, At, B1); PG8_BAR;
            }
        }
        if constexpr (ALIGN_EPI) { if (wr == 0) PG8_BAR; }
        if constexpr (FP8) asm volatile("s_nop 15\n\ts_nop 15" ::: "memory");
        { int tz = threadIdx.x; asm volatile("" : "+v"(tz)); const int wid_ = tz >> 6, lane_ = tz & 63; E(acc, cur, wid_ >> 2, wid_ & 3, lane_ & 15, lane_ >> 4); }
        if (!has_next) break;
#pragma unroll
        for (int a = 0; a < 2; ++a)
#pragma unroll
            for (int b = 0; b < 2; ++b)
#pragma unroll
                for (int m = 0; m < 4; ++m)
#pragma unroll
                    for (int n = 0; n < 2; ++n) acc[a][b][m][n] = (f32x4){0.f, 0.f, 0.f, 0.f};
        cur = nxt; cA = nA; cB0 = nB0; cB1 = nB1; ++ui;
        { int tz = threadIdx.x; asm volatile("" : "+v"(tz));
#pragma unroll
          for (int i = 0; i < 2; ++i) { int R_, C_; stage_rc(tz * 16 + i * 8192, R_, C_); cA0[i] = S.a_off(ui, cur, R_) + (unsigned)C_ * 2u; cA1[i] = S.a_off(ui, cur, HALF + R_) + (unsigned)C_ * 2u; } }
        if constexpr (ALIGN_EPI) { if (wr == 1) PG8_BAR; }
    }
    PG8_WAIT_V(0);
    if constexpr (!ALIGN_EPI) { if (wr == 0) PG8_BAR; }
    PG8_BAR;
#undef PG8_SA
#undef PG8_SB
#undef PG8_STAGE
#undef PG8_LDA
#undef PG8_LDB
#undef PG8_MMA
#undef PG8_WAIT_V
#undef PG8_WAIT_L
#undef PG8_BAR
#undef PG8_SCHED
}
}

__device__ __forceinline__ void moe_tables(const P& p, int l, LAS int* tb) {
    __syncthreads();
    if (TIDX < 64) { const int lane = TIDX; const int c = ((const int*)(p.ws + CTL_CNT))[(l * NE + (lane & 31)) * CNT_STRIDE]; const int pc = (c + 255) & ~255; int incl = pc;
#pragma unroll
        for (int o = 1; o < 32; o <<= 1) { const int t = __shfl_up(incl, o); if ((lane & 31) >= o) incl += t; }
        if (lane < 32) { tb[lane] = incl - pc; tb[64 + lane] = (incl - pc) >> 8; tb[128 + lane] = c; if (lane == 31) { tb[32] = incl; tb[96] = incl >> 8; } } }
    __syncthreads();
}


typedef int ud4 __attribute__((ext_vector_type(4)));
constexpr int LDS_TB = pg8::STAGE_BYTES, LDS_GT = LDS_TB + 1024, LDS_UT = LDS_GT + 12288, LDS_BT = LDS_UT + 256;
static_assert(LDS_BT + 12288 <= LDS_MISC, "LDS map");
__device__ __forceinline__ int moe_find_e(const LAS int* tb, int rbi) { int e = 0;
#pragma unroll 1
    for (int i = 1; i < 32; ++i) if (tb[64 + i] <= rbi) e = i;
    return e; }
__device__ __forceinline__ f32x4 swiglu4(f32x4 g, f32x4 l) {
    f32x4 gl, li, e, r;
#pragma unroll
    for (int j = 0; j < 4; ++j) { gl[j] = __builtin_fminf(g[j], 7.f); li[j] = __builtin_amdgcn_fmed3f(l[j], -7.f, 7.f); }
    const f32x4 t = gl * (-1.702f * 1.4426950408889634f);
#pragma unroll
    for (int j = 0; j < 4; ++j) e[j] = __builtin_amdgcn_exp2f(t[j]);
    const f32x4 d = e + 1.f;
#pragma unroll
    for (int j = 0; j < 4; ++j) r[j] = __builtin_amdgcn_rcpf(d[j]);
    return (gl * r) * (li * ACT_SCALE + ACT_SCALE); }

struct MoeDeal { int b0, nu, rank; };
template <int SH> __device__ __forceinline__ MoeDeal moe_deal(int nblk) { const int x = blockIdx.x & 7; const int b0 = x * nblk / 8, b1 = (x + 1) * nblk / 8; return MoeDeal{b0, (b1 - b0) << SH, (int)(blockIdx.x >> 3)}; }
template <int SH> __device__ __forceinline__ void moe_unit_table(LAS int* tb, LAS int* ut, const MoeDeal dl) {
    const int i = TIDX; if (i < 12) { const int j = i * 32 + dl.rank; ud4 d = {0, 0, 0, 0};
        if (j < dl.nu) { const int rbi = dl.b0 + (j >> SH), pn = j & ((1 << SH) - 1), e = moe_find_e(tb, rbi); d.x = tb[e] + (rbi - tb[64 + e]) * 256; d.y = pn; d.z = e; d.w = rbi - tb[64 + e]; }
        ((LAS ud4*)ut)[i] = d; }
    __syncthreads();
}
struct SchedMoe1 { const LAS int* ut; const LAS unsigned* gt; const char* Hb; const char* W1; int nunits, G, bid;
    __device__ __forceinline__ bool next(int i, pg8::GUnit& u) const { if (i * G + bid >= nunits) return false; const ud4 d = ((const LAS ud4*)ut)[i];
        u.a = Hb; u.b0 = W1 + (size_t)(d.z * 2 * DFF + d.y * 128) * D; u.b1 = u.b0 + (size_t)DFF * D;
        u.e0 = d.x; u.e1 = d.y * 128; u.e2 = d.z; u.e3 = i; return true; }
    __device__ __forceinline__ unsigned a_off(int i, const pg8::GUnit&, int R) const { return gt[i * 256 + R]; } };
struct EpiSwigluP { static constexpr bool PERM = true; static constexpr int VM_OPS = 4; unsigned char* Act; const LAS float* bt;
    __device__ __forceinline__ void operator()(const f32x4 (&acc)[2][2][4][2], const pg8::GUnit& u, int wr, int wc, int fr, int fq) const {
        const LAS float* bias = bt + u.e3 * 256 + wc * 32 + 8 * fq; const int odd = fq & 1; const int colb = u.e1 + wc * 32 + 8 * (fq - odd); const float ws = 1.f / W_SCALE;
        const f32x4 bg0 = *(const LAS f32x4*)(bias), bg1 = *(const LAS f32x4*)(bias + 4), bl0 = *(const LAS f32x4*)(bias + 128), bl1 = *(const LAS f32x4*)(bias + 132);
#pragma unroll
        for (int ai = 0; ai < 2; ++ai)
#pragma unroll
            for (int mp = 0; mp < 2; ++mp) { unsigned xy[2][2];
#pragma unroll
                for (int o = 0; o < 2; ++o) { const int m = 2 * mp + o;
                    const f32x4 v0 = swiglu4(acc[ai][0][m][0] * ws + bg0, acc[ai][1][m][0] * ws + bl0), v1 = swiglu4(acc[ai][0][m][1] * ws + bg1, acc[ai][1][m][1] * ws + bl1);
                    xy[o][0] = pk4_fp8(v0[0], v0[1], v0[2], v0[3]); xy[o][1] = pk4_fp8(v1[0], v1[1], v1[2], v1[3]); }
                const auto s0 = __builtin_amdgcn_permlane16_swap(xy[0][0], xy[1][0], false, false), s1 = __builtin_amdgcn_permlane16_swap(xy[0][1], xy[1][1], false, false);
                const size_t row = (size_t)(u.e0 + ai * 128 + wr * 64 + (2 * mp + odd) * 16 + fr);
                *(u32x4*)(Act + row * DFF + colb) = (u32x4){s0[0], s1[0], s0[1], s1[1]}; }
    } };
__device__ __forceinline__ void ph_moe1(const P& p, int l, LAS unsigned char* lds) {
    LAS int* tb = (LAS int*)(lds + LDS_TB); moe_tables(p, l, tb);
    LAS unsigned* gt = (LAS unsigned*)(lds + LDS_GT); LAS int* ut = (LAS int*)(lds + LDS_UT); LAS float* bt = (LAS float*)(lds + LDS_BT);
    const MoeDeal dl = moe_deal<3>(tb[96]); const int nunits = dl.nu, G = 32, bid = dl.rank;
    moe_unit_table<3>(tb, ut, dl);
    const int* list = (const int*)(p.ws + WS_ROUTE + RT_LIST); const int dummy = (l == 0) ? 0 : NCTX; const float* b1l = p.e_b1 + (size_t)l * NE * 2 * DFF;
    for (int q = TIDX; q < 12 * 256; q += 512) { const int i = q >> 8, R = q & 255; if (i * G + bid >= nunits) break; const ud4 d = ((const LAS ud4*)ut)[i];
        const int idx = d.w * 256 + R; const int row = idx < tb[128 + d.z] ? list[(size_t)d.z * NTOK + idx] : dummy;
        gt[q] = (unsigned)row * (unsigned)D;
        bt[q] = b1l[(size_t)d.z * 2 * DFF + (R < 128 ? d.y * 128 + R : DFF + d.y * 128 + (R - 128))]; }
    __syncthreads();
    SchedMoe1 S{ut, gt, (const char*)(p.ws + WS_HB8), (const char*)(p.ws + WS_W1T) + (size_t)l * NE * 2 * DFF * D, nunits, G, bid};
    EpiSwigluP E{(unsigned char*)(p.ws + WS_ACT), bt};
    pg8::gemm_phase<EpiSwigluP, SchedMoe1, true>(lds, D, S, E);
}
struct SchedMoe2 { const LAS int* ut; const char* Act; const char* W2; int nunits, G, bid;
    __device__ __forceinline__ bool next(int i, pg8::GUnit& u) const { if (i * G + bid >= nunits) return false; const ud4 d = ((const LAS ud4*)ut)[i];
        u.a = Act + (size_t)d.x * DFF; u.b0 = W2 + (size_t)(d.z * D + d.y * 256) * DFF; u.b1 = u.b0 + (size_t)128 * DFF;
        u.e0 = d.x; u.e1 = d.y * 256; u.e2 = d.z; u.e3 = i; return true; }
    __device__ __forceinline__ unsigned a_off(int, const pg8::GUnit&, int R) const { return (unsigned)R * (unsigned)DFF; } };
struct EpiBiasP { static constexpr bool PERM = true; static constexpr int VM_OPS = 8; unsigned char* Yb; const LAS float* bt;
    __device__ __forceinline__ void operator()(const f32x4 (&acc)[2][2][4][2], const pg8::GUnit& u, int wr, int wc, int fr, int fq) const {
        const int odd = fq & 1;
#pragma unroll
        for (int bj = 0; bj < 2; ++bj) { const int cl = bj * 128 + wc * 32 + 8 * fq; const f32x4 b0 = *(const LAS f32x4*)(bt + u.e3 * 256 + cl) * YB_SCALE, b1 = *(const LAS f32x4*)(bt + u.e3 * 256 + cl + 4) * YB_SCALE;
            const int colb = u.e1 + bj * 128 + wc * 32 + 8 * (fq - odd);
#pragma unroll
            for (int ai = 0; ai < 2; ++ai)
#pragma unroll
                for (int mp = 0; mp < 2; ++mp) { unsigned xy[2][2];
#pragma unroll
                    for (int o = 0; o < 2; ++o) { const int m = 2 * mp + o; f32x4 v0 = acc[ai][bj][m][0] * (YB_SCALE / (W_SCALE * ACT_SCALE)) + b0, v1 = acc[ai][bj][m][1] * (YB_SCALE / (W_SCALE * ACT_SCALE)) + b1;
#pragma unroll
                        for (int j = 0; j < 4; ++j) { v0[j] = __builtin_amdgcn_fmed3f(v0[j], -448.f, 448.f); v1[j] = __builtin_amdgcn_fmed3f(v1[j], -448.f, 448.f); }
                        xy[o][0] = pk4_fp8(v0[0], v0[1], v0[2], v0[3]); xy[o][1] = pk4_fp8(v1[0], v1[1], v1[2], v1[3]); }
                    const auto s0 = __builtin_amdgcn_permlane16_swap(xy[0][0], xy[1][0], false, false), s1 = __builtin_amdgcn_permlane16_swap(xy[0][1], xy[1][1], false, false);
                    const size_t row = (size_t)(u.e0 + ai * 128 + wr * 64 + (2 * mp + odd) * 16 + fr);
                    *(u32x4*)(Yb + row * D + colb) = (u32x4){s0[0], s1[0], s0[1], s1[1]}; } }
    } };
__device__ __forceinline__ void ph_moe2(const P& p, int l, LAS unsigned char* lds) {
    LAS int* tb = (LAS int*)(lds + LDS_TB); moe_tables(p, l, tb);
    LAS int* ut = (LAS int*)(lds + LDS_UT); LAS float* bt = (LAS float*)(lds + LDS_BT);
    const MoeDeal dl = moe_deal<2>(tb[96]); const int nunits = dl.nu, G = 32, bid = dl.rank;
    moe_unit_table<2>(tb, ut, dl);
    const float* b2l = p.e_b2 + (size_t)l * NE * D;
    for (int q = TIDX; q < 12 * 256; q += 512) { const int i = q >> 8, R = q & 255; if (i * G + bid >= nunits) break; const ud4 d = ((const LAS ud4*)ut)[i];
        bt[q] = b2l[(size_t)d.z * D + d.y * 256 + R]; }
    __syncthreads();
    SchedMoe2 S{ut, (const char*)(p.ws + WS_ACT), (const char*)(p.ws + WS_W2T) + (size_t)l * NE * D * DFF, nunits, G, bid};
    EpiBiasP E{(unsigned char*)(p.ws + WS_YB), bt};
    pg8::gemm_phase<EpiBiasP, SchedMoe2, true, true>(lds, DFF, S, E);
}

template <class AF, class BF, class EF>
__device__ __forceinline__ void kgemm_unit(LAS unsigned char* lds, const AF& af, const BF& bf, const EF& ef, int K) {
    const int tid = TIDX, lane = tid & 63, wid = tid >> 6, fr = lane & 15, fq = lane >> 4;
    const int ks = K >> 3, kb = wid * ks;
    f32x4 acc[4][4];
#pragma unroll
    for (int i = 0; i < 4; ++i)
#pragma unroll
        for (int j = 0; j < 4; ++j) acc[i][j] = (f32x4){0.f, 0.f, 0.f, 0.f};
    if (ks == 32) {
        bf16x8 a[4], b[4];
#pragma unroll
        for (int i = 0; i < 4; ++i) { a[i] = *(const bf16x8*)(af.row(i * 16 + fr) + kb + fq * 8); b[i] = *(const bf16x8*)(bf.row(i * 16 + fr) + kb + fq * 8); }
#pragma unroll
        for (int i = 0; i < 4; ++i)
#pragma unroll
            for (int j = 0; j < 4; ++j) acc[i][j] = __builtin_amdgcn_mfma_f32_16x16x32_bf16(b[j], a[i], acc[i][j], 0, 0, 0);
    } else {
        const bf16_t* ap[4]; const bf16_t* bp[4];
#pragma unroll
        for (int i = 0; i < 4; ++i) { ap[i] = af.row(i * 16 + fr) + kb + fq * 16; bp[i] = bf.row(i * 16 + fr) + kb + fq * 16; }
        bf16x8 a[2][4][2], b[2][4][2];
        const int npair = ks >> 6;
#pragma unroll
        for (int s = 0; s < 2; ++s) if (s < npair) {
#pragma unroll
            for (int i = 0; i < 4; ++i) { a[s][i][0] = *(const bf16x8*)(ap[i] + 64 * s); a[s][i][1] = *(const bf16x8*)(ap[i] + 64 * s + 8); b[s][i][0] = *(const bf16x8*)(bp[i] + 64 * s); b[s][i][1] = *(const bf16x8*)(bp[i] + 64 * s + 8); } }
        for (int s0 = 0; s0 < npair; s0 += 2) {
#pragma unroll
            for (int s = 0; s < 2; ++s) if (s0 + s < npair) {
#pragma unroll
                for (int h = 0; h < 2; ++h)
#pragma unroll
                    for (int i = 0; i < 4; ++i)
#pragma unroll
                        for (int j = 0; j < 4; ++j) acc[i][j] = __builtin_amdgcn_mfma_f32_16x16x32_bf16(b[s][j][h], a[s][i][h], acc[i][j], 0, 0, 0);
                if (s0 + s + 2 < npair) { const int o = 64 * (s0 + s + 2);
#pragma unroll
                    for (int i = 0; i < 4; ++i) { a[s][i][0] = *(const bf16x8*)(ap[i] + o); a[s][i][1] = *(const bf16x8*)(ap[i] + o + 8); b[s][i][0] = *(const bf16x8*)(bp[i] + o); b[s][i][1] = *(const bf16x8*)(bp[i] + o + 8); } }
            }
        }
    }
    constexpr int PP = 68;
    LAS float* P = (LAS float*)lds;
    __syncthreads();
#pragma unroll
    for (int i = 0; i < 4; ++i)
#pragma unroll
        for (int j = 0; j < 4; ++j) *(LAS f32x4*)(P + ((wid * 64 + i * 16 + fr) * PP + j * 16 + 4 * fq)) = acc[i][j];
    __syncthreads();
#pragma unroll
    for (int q = 0; q < 2; ++q) { const int e = tid + 512 * q, row = e >> 4, c4 = (e & 15) * 4; f32x4 v = *(const LAS f32x4*)(P + row * PP + c4);
#pragma unroll
        for (int w = 1; w < 8; ++w) v += *(const LAS f32x4*)(P + (w * 64 + row) * PP + c4);
        ef(row, c4, v); }
}

template <class EF>
__device__ __forceinline__ void kgemm8_unit(LAS unsigned char* lds, const unsigned char* A, size_t lda, const unsigned char* B, size_t ldb, int K, float scale, const EF& ef) {
    const int tid = TIDX, lane = tid & 63, wid = tid >> 6, fr = lane & 15, fq = lane >> 4;
    const int ks = K >> 3, kb = wid * ks, nstep = ks >> 7;
    f32x4 acc[4][4];
#pragma unroll
    for (int i = 0; i < 4; ++i)
#pragma unroll
        for (int j = 0; j < 4; ++j) acc[i][j] = (f32x4){0.f, 0.f, 0.f, 0.f};
    pg8::i32x8 a[2][4], b[2][4];
#pragma unroll
    for (int s2 = 0; s2 < 2; ++s2) if (s2 < nstep) {
#pragma unroll
        for (int i = 0; i < 4; ++i) { a[s2][i] = *(const pg8::i32x8*)(A + (size_t)(i * 16 + fr) * lda + kb + 128 * s2 + 32 * fq); b[s2][i] = *(const pg8::i32x8*)(B + (size_t)(i * 16 + fr) * ldb + kb + 128 * s2 + 32 * fq); } }
    const unsigned mx_one = 0x7f7f7f7fu;
#pragma unroll
    for (int s2 = 0; s2 < 2; ++s2) if (s2 < nstep) {
#pragma unroll
        for (int i = 0; i < 4; ++i)
#pragma unroll
            for (int j = 0; j < 4; ++j) asm volatile("v_mfma_scale_f32_16x16x128_f8f6f4 %0, %1, %2, %0, %3, %3 op_sel_hi:[0,0,0]" : "+v"(acc[i][j]) : "v"(b[s2][j]), "v"(a[s2][i]), "v"(mx_one)); }
    asm volatile("s_nop 15\n\ts_nop 15" ::: "memory");
    constexpr int PP = 68;
    LAS float* Pm = (LAS float*)lds;
    __syncthreads();
#pragma unroll
    for (int i = 0; i < 4; ++i)
#pragma unroll
        for (int j = 0; j < 4; ++j) *(LAS f32x4*)(Pm + ((wid * 64 + i * 16 + fr) * PP + j * 16 + 4 * fq)) = acc[i][j];
    __syncthreads();
#pragma unroll
    for (int q = 0; q < 2; ++q) { const int e = tid + 512 * q, row = e >> 4, c4 = (e & 15) * 4; f32x4 v = *(const LAS f32x4*)(Pm + row * PP + c4);
#pragma unroll
        for (int w = 1; w < 8; ++w) v += *(const LAS f32x4*)(Pm + (w * 64 + row) * PP + c4);
        ef(row, c4, v * scale); }
}

__device__ __forceinline__ int fourier_true_row(int m) {
    if (m < NCTX) return m; const int mm = m - NCTX, b = mm >> 13, rem = mm & 8191, cc = rem >> 7, rr = rem & 127; return NCTX + b * SEQ + rr * 64 + cc; }
template <bool FOURIER> __device__ __forceinline__ void epi_residual4(const P& p, int layer, int row  , int n, f32x4 v) {
    f32x4 xv;
    if (FOURIER) xv = *(const f32x4*)(((row < NCTX) ? p.ctx + (size_t)row * D : p.x + (size_t)(row - NCTX) * D) + n);
    else { const u32x2 w = *(const u32x2*)((const bf16_t*)(p.ws + WS_X2) + (size_t)row * D + n); xv = (f32x4){bf2f(w.x & 0xffffu), bf2f(w.x >> 16), bf2f(w.y & 0xffffu), bf2f(w.y >> 16)}; }
    const f32x4 gv = *(const f32x4*)(modp(p, layer, row_cond(row), 2) + n);
    st_bf4((bf16_t*)(p.ws + WS_X1) + (size_t)row * D + n, xv + gv * v); }
__device__ __forceinline__ void epi_hgrn4(const P& p, size_t row, int n  , f32x4 v) {
    const int seg = n >> 10, col = n & 1023;
    if (seg == 0) { f32x4 o; for (int j = 0; j < 4; ++j) o[j] = siluf_(v[j]); st_bf4((bf16_t*)(p.ws + WS_QB) + row * D + col, o); }
    else if (seg == 1 || seg == 2) { const f32x4 l4 = *(const f32x4*)((const float*)(p.ws + WS_LB) + (seg - 1) * D + col);
        typedef _Float16 h4 __attribute__((ext_vector_type(4))); h4 aa;
        for (int j = 0; j < 4; ++j) { const float s = __builtin_amdgcn_rcpf(1.f + __expf(-v[j])); const float fg = l4[j] + (1.f - l4[j]) * s; aa[j] = (_Float16)__logf(fg); }
        *(h4*)((_Float16*)(p.ws + (seg == 1 ? WS_AFW : WS_ABW)) + row * D + col) = aa; }
    else if (seg == 3) st_bf4((bf16_t*)(p.ws + WS_VB) + row * D + col, v);
    else { f32x4 o; for (int j = 0; j < 4; ++j) o[j] = siluf_(v[j]); st_bf4((bf16_t*)(p.ws + WS_SGB) + row * D + col, o); } }
struct KEpiBf16 { bf16_t* C; size_t ld; __device__ __forceinline__ void operator()(int r, int c, f32x4 v) const { st_bf4(C + (size_t)r * ld + c, v); } };
struct KEpiBf16F8 { bf16_t* C; unsigned char* C8; size_t ld; __device__ __forceinline__ void operator()(int r, int c, f32x4 v) const {
    *(unsigned*)(C8 + (size_t)r * ld + c) = pk4_fp8(v[0] * W_SCALE, v[1] * W_SCALE, v[2] * W_SCALE, v[3] * W_SCALE); } };
struct KEpiResF { const P* p; int row0, n0; __device__ __forceinline__ void operator()(int r, int c, f32x4 v) const { epi_residual4<true>(*p, 0, row0 + r, n0 + c, v); } };
struct KEpiHgrn { const P* p; int row0, n0; __device__ __forceinline__ void operator()(int r, int c, f32x4 v) const { epi_hgrn4(*p, (size_t)(row0 + r), n0 + c, v); } };

struct SchedDense { const char* A; const char* B; int RB, nM, nN, G, bid;
    __device__ __forceinline__ bool next(int i, pg8::GUnit& u) const { const int nwg = nM * nN; const long L = (long)i * G + bid; if (L >= nwg) return false;
        int wgid = (int)L; { const int q = nwg / 8, r = nwg % 8, xcd = wgid % 8, off = wgid / 8; wgid = (xcd < r ? xcd * (q + 1) : r * (q + 1) + (xcd - r) * q) + off; }
        const int nig = 8 * nN, gid = wgid / nig, fm = gid * 8, gsz = (nM - fm) < 8 ? (nM - fm) : 8; const int pm = fm + ((wgid % nig) % gsz), pn = (wgid % nig) / gsz;
        u.a = A + (size_t)pm * 256 * RB; u.b0 = B + (size_t)pn * 256 * RB; u.b1 = u.b0 + (size_t)128 * RB; u.e0 = pm * 256; u.e1 = pn * 256; u.e2 = 0; u.e3 = 0; return true; }
    __device__ __forceinline__ unsigned a_off(int, const pg8::GUnit&, int R) const { return (unsigned)R * (unsigned)RB; } };
template <bool FOURIER> struct EpiResidualP { static constexpr bool PERM = false; static constexpr int VM_OPS = 0; const P* p; int layer; float scale;
    struct XB { f32x4 f[2][2][2]; u32x2 h[2][2][2]; };
    __device__ __forceinline__ void load(XB& x, const pg8::GUnit& u, int b, int wr, int colb, int fr, int (&rows)[2]) const {
#pragma unroll
        for (int mi = 0; mi < 2; ++mi) { const int ai = b >> 1, m = (b & 1) * 2 + mi; const int mrow = NCTX + u.e0 + ai * 128 + wr * 64 + m * 16 + fr; const int row = FOURIER ? fourier_true_row(mrow) : mrow; rows[mi] = row;
#pragma unroll
            for (int bj = 0; bj < 2; ++bj)
#pragma unroll
                for (int n = 0; n < 2; ++n) { const int col = colb + bj * 128 + n * 16;
                    if constexpr (FOURIER) x.f[mi][bj][n] = *(const f32x4*)(p->x + (size_t)(row - NCTX) * D + col);
                    else x.h[mi][bj][n] = *(const u32x2*)((const bf16_t*)(p->ws + WS_X2) + (size_t)row * D + col); } } }
    __device__ __forceinline__ void operator()(const f32x4 (&acc)[2][2][4][2], const pg8::GUnit& u, int wr, int wc, int fr, int fq) const {
        const int colb = u.e1 + wc * 32 + 4 * fq;
        const float* gp = modp(*p, layer, u.e0 >> 13, 2) + colb;
        f32x4 g[2][2];
#pragma unroll
        for (int bj = 0; bj < 2; ++bj)
#pragma unroll
            for (int n = 0; n < 2; ++n) g[bj][n] = *(const f32x4*)(gp + bj * 128 + n * 16);
        XB xa, xb; int ra[2], rb[2];
        load(xa, u, 0, wr, colb, fr, ra);
#pragma unroll
        for (int b = 0; b < 4; ++b) {
            XB& cur = (b & 1) ? xb : xa; XB& nxt = (b & 1) ? xa : xb; int (&rc)[2] = (b & 1) ? rb : ra; int (&rn)[2] = (b & 1) ? ra : rb;
            if (b < 3) load(nxt, u, b + 1, wr, colb, fr, rn);
#pragma unroll
            for (int mi = 0; mi < 2; ++mi) { const int ai = b >> 1, m = (b & 1) * 2 + mi;
#pragma unroll
                for (int bj = 0; bj < 2; ++bj)
#pragma unroll
                    for (int n = 0; n < 2; ++n) { f32x4 xv;
                        if constexpr (FOURIER) xv = cur.f[mi][bj][n];
                        else { const u32x2 w = cur.h[mi][bj][n]; xv = (f32x4){bf2f(w.x & 0xffffu), bf2f(w.x >> 16), bf2f(w.y & 0xffffu), bf2f(w.y >> 16)}; }
                        st_bf4((bf16_t*)(p->ws + WS_X1) + (size_t)rc[mi] * D + colb + bj * 128 + n * 16, xv + g[bj][n] * (acc[ai][bj][m][n] * scale)); } } }
    } };
__device__ __forceinline__ float fast_silu(float v) { return v * __builtin_amdgcn_rcpf(1.f + __expf(-v)); }
__device__ __forceinline__ void epi_hgrn4_lds(const P& p, const LAS float* lbl, size_t row, int n  , f32x4 v) {
    const int seg = n >> 10, col = n & 1023;
    if (seg == 0) { f32x4 o; for (int j = 0; j < 4; ++j) o[j] = fast_silu(v[j]); st_bf4((bf16_t*)(p.ws + WS_QB) + row * D + col, o); }
    else if (seg == 1 || seg == 2) { const f32x4 l4 = *(const LAS f32x4*)(lbl + (seg - 1) * D + col);
        typedef _Float16 h4 __attribute__((ext_vector_type(4))); h4 aa;
        for (int j = 0; j < 4; ++j) { const float sg = __builtin_amdgcn_rcpf(1.f + __expf(-v[j])); const float fg = l4[j] + (1.f - l4[j]) * sg; aa[j] = (_Float16)__logf(fg); }
        *(h4*)((_Float16*)(p.ws + (seg == 1 ? WS_AFW : WS_ABW)) + row * D + col) = aa; }
    else if (seg == 3) st_bf4((bf16_t*)(p.ws + WS_VB) + row * D + col, v);
    else { f32x4 o; for (int j = 0; j < 4; ++j) o[j] = fast_silu(v[j]); st_bf4((bf16_t*)(p.ws + WS_SGB) + row * D + col, o); } }
struct EpiHgrnP { static constexpr bool PERM = true; static constexpr int VM_OPS = 16;
    const P* p; const LAS float* lbl;
    template <int SEG> __device__ __forceinline__ void body(const f32x4 (&acc)[2][2][4][2], const pg8::GUnit& u, int wr, int wc, int fr, int fq) const {
        const int colb = (u.e1 & 1023) + wc * 32 + 8 * fq;
        unsigned char* base = p->ws + (SEG == 0 ? WS_QB : SEG == 1 ? WS_AFW : SEG == 2 ? WS_ABW : SEG == 3 ? WS_VB : WS_SGB);
#pragma unroll
        for (int bj = 0; bj < 2; ++bj) { const int col = colb + bj * 128;
            f32x4 la = {0.f, 0.f, 0.f, 0.f}, lb = la;
            if constexpr (SEG == 1 || SEG == 2) { la = *(const LAS f32x4*)(lbl + (SEG - 1) * D + col); lb = *(const LAS f32x4*)(lbl + (SEG - 1) * D + col + 4); }
#pragma unroll
            for (int ai = 0; ai < 2; ++ai)
#pragma unroll
                for (int m = 0; m < 4; ++m) { const size_t row = (size_t)(NCTX + u.e0 + ai * 128 + wr * 64 + m * 16 + fr);
                    const f32x4 v0 = acc[ai][bj][m][0] * (1.f / W_SCALE), v1 = acc[ai][bj][m][1] * (1.f / W_SCALE); u32x4 w;
                    if constexpr (SEG == 1 || SEG == 2) { typedef _Float16 h2 __attribute__((ext_vector_type(2)));
                        const f32x4 t0 = v0 * -1.4426950408889634f, t1 = v1 * -1.4426950408889634f; f32x4 e0, e1;
#pragma unroll
                        for (int j = 0; j < 4; ++j) { e0[j] = __builtin_amdgcn_exp2f(t0[j]); e1[j] = __builtin_amdgcn_exp2f(t1[j]); }
                        const f32x4 d0 = e0 + 1.f, d1 = e1 + 1.f; f32x4 s0, s1;
#pragma unroll
                        for (int j = 0; j < 4; ++j) { s0[j] = __builtin_amdgcn_rcpf(d0[j]); s1[j] = __builtin_amdgcn_rcpf(d1[j]); }
                        const f32x4 f0 = la + (1.f - la) * s0, f1 = lb + (1.f - lb) * s1; f32x4 g0, g1;
#pragma unroll
                        for (int j = 0; j < 4; ++j) { g0[j] = __builtin_amdgcn_logf(f0[j]); g1[j] = __builtin_amdgcn_logf(f1[j]); }
                        const f32x4 a0 = g0 * 0.6931471805599453f, a1 = g1 * 0.6931471805599453f;
                        const h2 h0 = {(_Float16)a0[0], (_Float16)a0[1]}, h1 = {(_Float16)a0[2], (_Float16)a0[3]}, h2_ = {(_Float16)a1[0], (_Float16)a1[1]}, h3 = {(_Float16)a1[2], (_Float16)a1[3]};
                        w = (u32x4){__builtin_bit_cast(unsigned, h0), __builtin_bit_cast(unsigned, h1), __builtin_bit_cast(unsigned, h2_), __builtin_bit_cast(unsigned, h3)}; }
                    else if constexpr (SEG == 3) { w = (u32x4){pk2(v0[0], v0[1]), pk2(v0[2], v0[3]), pk2(v1[0], v1[1]), pk2(v1[2], v1[3])}; }
                    else { const f32x4 t0 = v0 * -1.4426950408889634f, t1 = v1 * -1.4426950408889634f; f32x4 e0, e1;
#pragma unroll
                        for (int j = 0; j < 4; ++j) { e0[j] = __builtin_amdgcn_exp2f(t0[j]); e1[j] = __builtin_amdgcn_exp2f(t1[j]); }
                        const f32x4 d0 = e0 + 1.f, d1 = e1 + 1.f; f32x4 s0, s1;
#pragma unroll
                        for (int j = 0; j < 4; ++j) { s0[j] = __builtin_amdgcn_rcpf(d0[j]); s1[j] = __builtin_amdgcn_rcpf(d1[j]); }
                        const f32x4 o0 = v0 * s0, o1 = v1 * s1;
                        w = (u32x4){pk2(o0[0], o0[1]), pk2(o0[2], o0[3]), pk2(o1[0], o1[1]), pk2(o1[2], o1[3])}; }
                    *(u32x4*)(base + (row * D + col) * 2) = w; } }
    }
    __device__ __forceinline__ void operator()(const f32x4 (&acc)[2][2][4][2], const pg8::GUnit& u, int wr, int wc, int fr, int fq) const {
        const int seg = __builtin_amdgcn_readfirstlane(u.e1 >> 10);
        if (seg == 0) body<0>(acc, u, wr, wc, fr, fq); else if (seg == 1) body<1>(acc, u, wr, wc, fr, fq); else if (seg == 2) body<2>(acc, u, wr, wc, fr, fq);
        else if (seg == 3) body<3>(acc, u, wr, wc, fr, fq); else body<4>(acc, u, wr, wc, fr, fq);
    } };

__device__ __forceinline__ void ph_fprep1(const P& p, LAS unsigned char* lds) {
    for (int u = blockIdx.x; u < 512; u += gridDim.x) { const int type = u >> 8, g = (u >> 6) & 3, mt = (u >> 2) & 15, nt = u & 3;
        RowsDense af{(const bf16_t*)(p.ws + WS_WINB) + (size_t)(mt * 64) * D + g * 256, D};
        RowsDense bf{(const bf16_t*)(p.ws + WS_TAB + (type ? TAB_S256 : TAB_C256)) + (size_t)(nt * 64) * 256, 256};
        KEpiBf16 ef{(bf16_t*)(p.ws + WS_TAB2) + (size_t)(type * D + mt * 64) * D + g * 256 + nt * 64, D};
        kgemm_unit(lds, af, bf, ef, 256); }
}
__device__ __forceinline__ void ph_fprep2(const P& p, LAS unsigned char* lds) {
    for (int u = blockIdx.x; u < 512; u += gridDim.x) { const int mt = u >> 5, nt = u & 31;
        RowsDense af{(const bf16_t*)(p.ws + WS_WOUTT) + (size_t)(mt * 64) * D, D};
        RowsDense bf{(const bf16_t*)(p.ws + WS_TAB2) + (size_t)(nt * 64) * D, D};
        KEpiBf16F8 ef{(bf16_t*)(p.ws + WS_WABT) + (size_t)(mt * 64) * 2 * D + nt * 64, (unsigned char*)(p.ws + WS_WABT8) + (size_t)(mt * 64) * 2 * D + nt * 64, 2 * D};
        kgemm_unit(lds, af, bf, ef, D); }
}
__device__ __forceinline__ int xt_swz(int col) { return ((col >> 2) + 2 * (col & 3)) & 7; }
__device__ __forceinline__ void ph_mod1_cdft(const P& p, LAS unsigned char* lds) {
    const int tid = TIDX, lane = tid & 63, wave = tid >> 6, G = gridDim.x, bid = blockIdx.x;
    bf16_t* Hb = (bf16_t*)(p.ws + WS_HB); bf16_t* Z1 = (bf16_t*)(p.ws + WS_Z1); const bf16_t* tb = (const bf16_t*)(p.ws + WS_TAB);
    { const int gw = bid * 8 + wave, NGW = G * 8; RowVec a, sh; ld_modvec(p, p.norm1_g, 0, 2, 0, lane, a, sh);
      for (int row = gw; row < NCTX; row += NGW) { RowVec x = ld_row_f32(p.ctx + (size_t)row * D, lane); const float rs = row_rs(x);
#pragma unroll
          for (int j = 0; j < 4; ++j) x.v[j] = x.v[j] * rs * a.v[j] + sh.v[j];
          st_row_bf16(Hb + (size_t)row * D, lane, x); } }
    DftT<64, false> T; dft_load_t<64, false>(T, tb + TAB_T64 / 2, nullptr);
    for (int u = bid; u < NBATCH * 128; u += G) { const int b = u >> 7, r = u & 127;
        RowVec a, sh; ld_modvec(p, p.norm1_g, 0, b, 0, lane, a, sh);
        const float* xb = p.x + ((size_t)b * SEQ + r * 64 + wave * 8) * D;
        unsigned pk[4][4][4];
#pragma unroll
        for (int tp = 0; tp < 4; ++tp) { const RowVec x0 = ld_row_f32(xb + (size_t)(2 * tp) * D, lane), x1 = ld_row_f32(xb + (size_t)(2 * tp + 1) * D, lane);
            const float rs0 = row_rs(x0), rs1 = row_rs(x1);
#pragma unroll
            for (int j = 0; j < 4; ++j) { const f32x4 h0 = x0.v[j] * rs0 * a.v[j] + sh.v[j], h1 = x1.v[j] * rs1 * a.v[j] + sh.v[j];
#pragma unroll
                for (int e = 0; e < 4; ++e) pk[j][e][tp] = pk2(h0[e], h1[e]); }
            asm volatile("" ::: "memory"); }
        __syncthreads();
        { int tw = threadIdx.x; asm volatile("" : "+v"(tw)); const int lz = tw & 63, wz = tw >> 6;
#pragma unroll
          for (int j = 0; j < 4; ++j)
#pragma unroll
            for (int e = 0; e < 4; ++e) { const int col = 256 * j + 4 * lz + e;
                *(LAS u32x4*)(lds + col * 128 + ((wz ^ xt_swz(col)) << 4)) = (u32x4){pk[j][e][0], pk[j][e][1], pk[j][e][2], pk[j][e][3]}; } }
        lds_barrier();
        int tz = threadIdx.x; asm volatile("" : "+v"(tz));
        const int fr = tz & 15, fq = (tz >> 4) & 3, m = (tz >> 6) * 16 + fr; bf16_t* orow = Z1 + (size_t)(NCTX + b * SEQ + r) * 2 * D + (size_t)(m & 63) * 128 * 2 * D + (m >= 64 ? D : 0);
        CvtRegs cr; bool cv = false;
#pragma unroll 1
        for (int cb = 0; cb < 16; ++cb) {
            if ((cb & 1) == 0 && cb < 6) cv = bg_issue(cr, p, 0, cb >> 1);
            f32x4 acc[4];
#pragma unroll
            for (int ni = 0; ni < 4; ++ni) acc[ni] = (f32x4){0.f, 0.f, 0.f, 0.f};
#pragma unroll
            for (int ks = 0; ks < 2; ++ks)
#pragma unroll
                for (int ni = 0; ni < 4; ++ni) { const int col = cb * 64 + ni * 16 + fr; const bf16x8 xf = *(const LAS bf16x8*)(lds + col * 128 + (((ks * 4 + fq) ^ xt_swz(col)) << 4));
                    acc[ni] = __builtin_amdgcn_mfma_f32_16x16x32_bf16(xf, T.t[0][ks][0], acc[ni], 0, 0, 0); }
#pragma unroll
            for (int ni = 0; ni < 4; ++ni) { if ((m & 63) <= 32) st_bf4(orow + cb * 64 + ni * 16 + 4 * fq, acc[ni]); }
            if ((cb & 1) == 1 && cv) { bg_finish(cr, p, 0, cb >> 1); cv = false; } }
    }
    __syncthreads();
}
__device__ __forceinline__ void ph_ctxdft(const P& p, LAS unsigned char* lds) {
    const bf16_t* Hb = (const bf16_t*)(p.ws + WS_HB); bf16_t* Z = (bf16_t*)(p.ws + WS_Z); const bf16_t* tb = (const bf16_t*)(p.ws + WS_TAB);
    for (int u = blockIdx.x; u < 32; u += gridDim.x) { const int b = u >> 4, cb = u & 15; DftRegs<256, false> xr;
        dft_fetch<256, false>(xr, Hb + (size_t)(b * CTXL) * D + cb * 64, nullptr, D);
        __syncthreads(); dft_stage<256, false>(lds, xr); __syncthreads();
        dft_compute_stream<256, true>(lds, tb + TAB_T256 / 2, (bf16_t*)(p.ws + WS_Z8C + (size_t)(b * CTXL) * 2 * D + cb * 64), 2 * D); }
    __syncthreads();
}
__device__ __forceinline__ void ph_rdft(const P& p, LAS unsigned char* lds) {
    const bf16_t* Z1 = (const bf16_t*)(p.ws + WS_Z1); bf16_t* Z = (bf16_t*)(p.ws + WS_Z); const bf16_t* tb = (const bf16_t*)(p.ws + WS_TAB); const int G = gridDim.x;
    DftT<128, true> T; dft_load_t<128, true>(T, tb + TAB_T128A / 2, tb + TAB_T128B / 2);
    DftRegs<128, true> xr; int u = blockIdx.x;
    auto base = [&](int v) { const int b = v >> 10, cc = (v >> 4) & 63, cb = v & 15; return (size_t)(NCTX + b * SEQ + cc * 128) * 2 * D + cb * 64; };
    auto sbase = [&](int v) { const int b = v >> 10, cc = (v >> 4) & 63, cb = v & 15, cs = cc > 32 ? 64 - cc : cc; return (size_t)(NCTX + b * SEQ + cs * 128) * 2 * D + cb * 64; };
    auto sflip = [&](int v) -> unsigned { return (((v >> 4) & 63) > 32) ? 0x80008000u : 0u; };
    if (u < 2048) dft_fetch<128, true>(xr, Z1 + sbase(u), Z1 + sbase(u) + D, 2 * D);
    __syncthreads();
    for (int it = 0; u < 2048; u += G, ++it) { LAS unsigned char* buf = lds + (it & 1) * 40960;
        dft_stage<128, true>(buf, xr, sflip(u));
        if (u + G < 2048) dft_fetch<128, true>(xr, Z1 + sbase(u + G), Z1 + sbase(u + G) + D, 2 * D);
        CvtRegs cr; const bool cv = ((it & 1) == 1) && (it < 8) && bg_issue(cr, p, 0, 3 + (it >> 1));
        lds_barrier();
        { const int b_ = u >> 10, cc_ = (u >> 4) & 63, cb_ = u & 15;
          dft_compute<128, true, true>(buf, T, (bf16_t*)(p.ws + WS_Z8 + (size_t)(b_ * SEQ + cc_ * 128) * 2 * D + cb_ * 64), 2 * D); }
        if (cv) bg_finish(cr, p, 0, 3 + (it >> 1)); }
    __syncthreads();
}
__device__ __forceinline__ void ph_gemm_f(const P& p, LAS unsigned char* lds) {
    for (int u = blockIdx.x; u < 128; u += gridDim.x) { const int mt = u >> 4, nt = u & 15;
        KEpiResF ef{&p, mt * 64, nt * 64};
        kgemm8_unit(lds, (const unsigned char*)(p.ws + WS_Z8C) + (size_t)(mt * 64) * 2 * D, 2 * D, (const unsigned char*)(p.ws + WS_WABT8) + (size_t)(nt * 64) * 2 * D, 2 * D, 2 * D, 1.f / W_SCALE, ef); }
    __syncthreads();
    SchedDense S{(const char*)(p.ws + WS_Z8), (const char*)(p.ws + WS_WABT8), 2 * D, NLAT / 256, D / 256, (int)gridDim.x, (int)blockIdx.x};
    EpiResidualP<true> E{&p, 0, 1.f / W_SCALE};
    pg8::gemm_phase<EpiResidualP<true>, SchedDense, true>(lds, 2 * D, S, E);
}

__device__ __forceinline__ void ph_gemm_hi(const P& p, LAS unsigned char* lds) {
    for (int u = blockIdx.x; u < 384; u += gridDim.x) { const int mt = u / 48, nt = 16 + u % 48;
        KEpiHgrn ef{&p, mt * 64, nt * 64};
        kgemm8_unit(lds, (const unsigned char*)(p.ws + WS_HBH8) + (size_t)(mt * 64) * D, D, (const unsigned char*)(p.ws + WS_WHIT8) + (size_t)(nt * 64) * D, D, D, 1.f / W_SCALE, ef); }
    LAS float* lbl = (LAS float*)(lds + LDS_BT);
    for (int q = TIDX; q < 2048; q += 512) lbl[q] = ((const float*)(p.ws + WS_LB))[q];
    __syncthreads();
    SchedDense S{(const char*)(p.ws + WS_HBH8) + (size_t)NCTX * D, (const char*)(p.ws + WS_WHIT8), D, NLAT / 256, NHI / 256, (int)gridDim.x, (int)blockIdx.x};
    EpiHgrnP E{&p, lbl};
    pg8::gemm_phase<EpiHgrnP, SchedDense, true>(lds, D, S, E);
}
__device__ __forceinline__ void ph_gemm_ho(const P& p, LAS unsigned char* lds) {
    SchedDense S{(const char*)(p.ws + WS_YR), (const char*)(p.ws + WS_WHOT), D, NLAT / 256, D / 256, (int)gridDim.x, (int)blockIdx.x};
    EpiResidualP<false> E{&p, 1, 1.f / W_SCALE};
    pg8::gemm_phase<EpiResidualP<false>, SchedDense, true>(lds, D, S, E);
}
constexpr int SC_QD = 0, SC_KG = 8704, SC_KT = 17408, SC_VT = 27648, SC_ET = 37888, SC_SET = 38400;
__device__ __forceinline__ int scan_pos(int ch) { const int kl = ch & 31; return (ch & ~31) + ((kl < 16) ? 8 * (kl >> 2) + (kl & 3) : 8 * ((kl - 16) >> 2) + 4 + (kl & 3)); }
template <bool OUTPUT>
__device__ __forceinline__ void scan_unit_mfma(const P& p, int unit, LAS unsigned char* lds) {
    const int tid = TIDX, lane = tid & 63, wid = __builtin_amdgcn_readfirstlane(tid >> 6), fr = lane & 15, fq = lane >> 4;
    const int ch = wid * 16 + fr, g = fq;
    const int stream = unit >> 3, part = unit & 7, b = stream >> 4, h = (stream >> 1) & 7, dir = stream & 1;
    int p0, nchunk;
    if (!OUTPUT) { if (part == 0) { p0 = 0; nchunk = CTXL / 32; } else { p0 = CTXL + (part - 1) * 1024; nchunk = 32; } }
    else { p0 = CTXL + part * 1024; nchunk = 32; }
    const _Float16* Ab = (const _Float16*)(p.ws + (dir ? WS_ABW : WS_AFW)) + h * HD + ch;
    const bf16_t* Vb = (const bf16_t*)(p.ws + WS_VB) + h * HD + ch; const bf16_t* Qb = (const bf16_t*)(p.ws + WS_QB) + h * HD + ch;
    float* Sloc = (float*)(p.ws + WS_SLOC); float* Dsum = (float*)(p.ws + WS_DSUM);
    f32x4 S[8];
#pragma unroll
    for (int kt = 0; kt < 8; ++kt) S[kt] = (f32x4){0.f, 0.f, 0.f, 0.f};
    if (OUTPUT) {
        f32x4 ns[8], nd[8];
#define SC_FOLD_LOAD(uu) do { const float* sl_ = Sloc + (size_t)(stream * 8 + (uu)) * 16384 + (((wid * 8) * 64 + lane) << 2); const float* dd_ = Dsum + (size_t)(stream * 8 + (uu)) * 128 + 4 * fq; \
            _Pragma("unroll") for (int kt = 0; kt < 8; ++kt) { ns[kt] = *(const f32x4*)(sl_ + kt * 256); nd[kt] = *(const f32x4*)(dd_ + kt * 16); } } while (0)
        SC_FOLD_LOAD(0);
        for (int u = 0; u <= part; ++u) { f32x4 cs[8], cd[8];
#pragma unroll
            for (int kt = 0; kt < 8; ++kt) { cs[kt] = ns[kt]; cd[kt] = nd[kt]; }
            if (u < part) SC_FOLD_LOAD(u + 1);
#pragma unroll
            for (int kt = 0; kt < 8; ++kt)
#pragma unroll
                for (int r = 0; r < 4; ++r) S[kt][r] = __expf(cd[kt][r]) * S[kt][r] + cs[kt][r]; }
#undef SC_FOLD_LOAD
    }
    float tsum = 0.f;
    auto rowof = [&](int pp) -> int { if (pp < CTXL) return b * CTXL + (dir ? CTXL - 1 - pp : pp); const int q = pp - CTXL; return NCTX + b * SEQ + (dir ? SEQ - 1 - q : q); };
    const int step = dir ? -1 : 1;
    const int sp0 = (g < 2) ? 16 * g : 16 * (g - 2) + 4, sp1 = sp0 + 8;
    const int kpos = scan_pos(ch);
    LAS unsigned char* scr = lds + 2 * SC_SET + wid * 3072;
    const int ft = lane >> 1, fh = lane & 1;
    const size_t foff = (size_t)h * HD + wid * 16 + fh * 8;
    const _Float16* Ag = (const _Float16*)(p.ws + (dir ? WS_ABW : WS_AFW)); const bf16_t* Vg = (const bf16_t*)(p.ws + WS_VB); const bf16_t* Qg = (const bf16_t*)(p.ws + WS_QB);
    u32x4 fa, fv, fqv = {0u, 0u, 0u, 0u};
    { const size_t o = (size_t)rowof(p0 + ft) * D + foff; fa = *(const u32x4*)(Ag + o); fv = *(const u32x4*)(Vg + o); if (OUTPUT) fqv = *(const u32x4*)(Qg + o); }
    __syncthreads();
    for (int ci = 0; ci < nchunk; ++ci) {
        LAS unsigned char* set = lds + (ci & 1) * SC_SET;
        *(LAS u32x4*)(scr + lane * 16) = fa; *(LAS u32x4*)(scr + 1024 + lane * 16) = fv; if (OUTPUT) *(LAS u32x4*)(scr + 2048 + lane * 16) = fqv;
        if (ci + 1 < nchunk) { const size_t o = (size_t)rowof(p0 + 32 * (ci + 1) + ft) * D + foff; fa = *(const u32x4*)(Ag + o); fv = *(const u32x4*)(Vg + o); if (OUTPUT) fqv = *(const u32x4*)(Qg + o); }
        CvtRegs cr; const int cslot = ci >> 2;
        const bool cv = OUTPUT && (ci & 3) == 2 && ci < 28 && bg_issue(cr, p, 1, cslot);
        asm volatile("" ::: "memory");
        _Float16 av[8]; bf16_t qv[8], vv[8];
#pragma unroll
        for (int j = 0; j < 8; ++j) { const int so = (8 * g + j) * 32 + fr * 2; av[j] = *(const LAS _Float16*)(scr + so); vv[j] = *(const LAS bf16_t*)(scr + 1024 + so); if (OUTPUT) qv[j] = *(const LAS bf16_t*)(scr + 2048 + so); else qv[j] = 0; }
        float c[8]; float run = 0.f;
#pragma unroll
        for (int j = 0; j < 8; ++j) { run += (float)av[j]; c[j] = run; }
        float incl = run; { const float u1 = __shfl_up(incl, 16); if (g >= 1) incl += u1; const float u2 = __shfl_up(incl, 32); if (g >= 2) incl += u2; }
        const float m = incl - run, T = __shfl(incl, 48 + fr);
        { unsigned kd[4], vp[4];
#pragma unroll
          for (int j2 = 0; j2 < 4; ++j2) { float kdv[2];
#pragma unroll
              for (int e = 0; e < 2; ++e) { const int j = 2 * j2 + e; const float cf = m + c[j]; const float kk = 1.f - __expf((float)av[j]); kdv[e] = kk * __expf(T - cf);
                  if (OUTPUT) { const float e1 = __expf(cf); const float qd = bf2f(qv[j]) * e1; const float kg = kk * __expf(fminf(-cf, 80.f)); const int t = 8 * g + j;
                      *(LAS bf16_t*)(set + SC_QD + t * 272 + kpos * 2) = (bf16_t)f2bf(qd); *(LAS bf16_t*)(set + SC_KG + t * 272 + kpos * 2) = (bf16_t)f2bf(kg); } }
              kd[j2] = pk2(kdv[0], kdv[1]); vp[j2] = (unsigned)vv[2 * j2] | ((unsigned)vv[2 * j2 + 1] << 16); }
          *(LAS u32x2*)(set + SC_KT + ch * 80 + sp0 * 2) = (u32x2){kd[0], kd[1]}; *(LAS u32x2*)(set + SC_KT + ch * 80 + sp1 * 2) = (u32x2){kd[2], kd[3]};
          *(LAS u32x2*)(set + SC_VT + ch * 80 + sp0 * 2) = (u32x2){vp[0], vp[1]}; *(LAS u32x2*)(set + SC_VT + ch * 80 + sp1 * 2) = (u32x2){vp[2], vp[3]}; }
        if (g == 0) { *(LAS float*)(set + SC_ET + ch * 4) = __expf(T); tsum += T; }
        lds_barrier();
        const bf16x8 vfrag = *(const LAS bf16x8*)(set + SC_VT + (wid * 16 + fr) * 80 + fq * 16);
        if (OUTPUT) {
            bf16x8 bq[2][4];
#pragma unroll
            for (int tt = 0; tt < 2; ++tt)
#pragma unroll
                for (int ks = 0; ks < 4; ++ks) bq[tt][ks] = *(const LAS bf16x8*)(set + SC_QD + (tt * 16 + fr) * 272 + ks * 64 + fq * 16);
            f32x4 p00 = (f32x4){0.f, 0.f, 0.f, 0.f}, p01 = p00, p11 = p00;
#pragma unroll
            for (int ks = 0; ks < 4; ++ks) { const bf16x8 ak0 = *(const LAS bf16x8*)(set + SC_KG + fr * 272 + ks * 64 + fq * 16), ak1 = *(const LAS bf16x8*)(set + SC_KG + (16 + fr) * 272 + ks * 64 + fq * 16);
                p00 = __builtin_amdgcn_mfma_f32_16x16x32_bf16(ak0, bq[0][ks], p00, 0, 0, 0); p01 = __builtin_amdgcn_mfma_f32_16x16x32_bf16(ak0, bq[1][ks], p01, 0, 0, 0);
                p11 = __builtin_amdgcn_mfma_f32_16x16x32_bf16(ak1, bq[1][ks], p11, 0, 0, 0); }
#pragma unroll
            for (int r = 0; r < 4; ++r) if (4 * fq + r > fr) { p00[r] = 0.f; p11[r] = 0.f; }
            f32x4 oacc[2]; oacc[0] = (f32x4){0.f, 0.f, 0.f, 0.f}; oacc[1] = oacc[0];
#pragma unroll
            for (int ks = 0; ks < 4; ++ks) { union { u32x4 u; bf16x8 v; } sa; sa.u = (u32x4){pk2(S[2 * ks][0], S[2 * ks][1]), pk2(S[2 * ks][2], S[2 * ks][3]), pk2(S[2 * ks + 1][0], S[2 * ks + 1][1]), pk2(S[2 * ks + 1][2], S[2 * ks + 1][3])};
#pragma unroll
                for (int tt = 0; tt < 2; ++tt) oacc[tt] = __builtin_amdgcn_mfma_f32_16x16x32_bf16(sa.v, bq[tt][ks], oacc[tt], 0, 0, 0); }
            { union { u32x4 u; bf16x8 v; } pb0, pb1; pb0.u = (u32x4){pk2(p00[0], p00[1]), pk2(p00[2], p00[3]), 0u, 0u}; pb1.u = (u32x4){pk2(p01[0], p01[1]), pk2(p01[2], p01[3]), pk2(p11[0], p11[1]), pk2(p11[2], p11[3])};
              oacc[0] = __builtin_amdgcn_mfma_f32_16x16x32_bf16(vfrag, pb0.v, oacc[0], 0, 0, 0); oacc[1] = __builtin_amdgcn_mfma_f32_16x16x32_bf16(vfrag, pb1.v, oacc[1], 0, 0, 0); }
            bf16_t* Ob = (bf16_t*)(p.ws + (dir ? WS_OBW : WS_OFW));
#pragma unroll
            for (int tt = 0; tt < 2; ++tt) { const int row = rowof(p0 + 32 * ci + tt * 16 + fr) - NCTX; st_bf4(Ob + (size_t)row * D + h * HD + wid * 16 + 4 * fq, oacc[tt]); }
        }
#pragma unroll
        for (int kt = 0; kt < 8; ++kt) { const f32x4 e4 = *(const LAS f32x4*)(set + SC_ET + (kt * 16 + 4 * fq) * 4); S[kt] = S[kt] * e4;
            const bf16x8 ak = *(const LAS bf16x8*)(set + SC_KT + (kt * 16 + fr) * 80 + fq * 16); S[kt] = __builtin_amdgcn_mfma_f32_16x16x32_bf16(ak, vfrag, S[kt], 0, 0, 0); }
        if (cv) bg_finish(cr, p, 1, cslot);
    }
    if (!OUTPUT) { float* sl = Sloc + (size_t)(stream * 8 + part) * 16384 + (((wid * 8) * 64 + lane) << 2);
#pragma unroll
        for (int kt = 0; kt < 8; ++kt) *(f32x4*)(sl + kt * 256) = S[kt];
        if (g == 0) Dsum[(size_t)(stream * 8 + part) * 128 + ch] = tsum; }
    __syncthreads();
}

__device__ __forceinline__ void ph_readout(const P& p) {
    const int lane = TIDX & 63, gw = blockIdx.x * 8 + (TIDX >> 6), NGW = gridDim.x * 8;
    const bf16_t* Of = (const bf16_t*)(p.ws + WS_OFW); const bf16_t* Ob = (const bf16_t*)(p.ws + WS_OBW); const bf16_t* SG = (const bf16_t*)(p.ws + WS_SGB) + (size_t)NCTX * D; bf16_t* Yr = (bf16_t*)(p.ws + WS_YR);
    const RowVec ng = ld_row_f32(p.h_norm_g, lane);
    u32x2 an[4], cn[4], gn[4];
#define RO_LOAD(rr) do { _Pragma("unroll") for (int j = 0; j < 4; ++j) { const size_t off_ = (size_t)(rr) * D + 256 * j + 4 * lane; an[j] = *(const u32x2*)(Of + off_); cn[j] = *(const u32x2*)(Ob + off_); gn[j] = *(const u32x2*)(SG + off_); } } while (0)
    if (gw < NLAT) RO_LOAD(gw);
    for (int r = gw; r < NLAT; r += NGW) { RowVec o; u32x2 a4[4], c4[4], g4[4];
#pragma unroll
        for (int j = 0; j < 4; ++j) { a4[j] = an[j]; c4[j] = cn[j]; g4[j] = gn[j]; }
        if (r + NGW < NLAT) RO_LOAD(r + NGW);
#pragma unroll
        for (int j = 0; j < 4; ++j) { const u32x2 a = a4[j], c = c4[j], g = g4[j];
            f32x4 v; v.x = bf2f(a.x & 0xffffu) + bf2f(c.x & 0xffffu); v.y = bf2f(a.x >> 16) + bf2f(c.x >> 16); v.z = bf2f(a.y & 0xffffu) + bf2f(c.y & 0xffffu); v.w = bf2f(a.y >> 16) + bf2f(c.y >> 16);
            float s = (v.x * v.x + v.y * v.y) + (v.z * v.z + v.w * v.w);
#pragma unroll
            for (int q = 1; q < 32; q <<= 1) s += __shfl_xor(s, q);
            const float rs = rsqrtf(s * (1.f / HD) + EPS);
            f32x4 gg; gg.x = bf2f(g.x & 0xffffu); gg.y = bf2f(g.x >> 16); gg.z = bf2f(g.y & 0xffffu); gg.w = bf2f(g.y >> 16);
            o.v[j] = v * rs * ng.v[j] * gg; }
#pragma unroll
        for (int j = 0; j < 4; ++j) { f32x4 c = o.v[j];
#pragma unroll
            for (int q = 0; q < 4; ++q) c[q] = __builtin_amdgcn_fmed3f(c[q], -448.f, 448.f);
            *(unsigned*)((unsigned char*)Yr + (size_t)r * D + 256 * j + 4 * lane) = pk4_fp8(c[0], c[1], c[2], c[3]); } }
#undef RO_LOAD
}

#define XB_TMO      128
#define XB_XCNT(j)  (256  + 64 * (j))
#define XB_XSUB(j)  (1280 + 64 * (j))
#define XB_XGEN(j)  (2304 + 64 * (j))
#define XB_TOP      3328
#define XB_TOPGEN   3392
#define XCD_BAR_WORDS 3456
#define XB_SPIN_CAP (1u << 18)
__device__ __forceinline__ unsigned xb_ld(unsigned* p)              { return __hip_atomic_load(p, __ATOMIC_RELAXED, __HIP_MEMORY_SCOPE_AGENT); }
__device__ __forceinline__ unsigned xb_add(unsigned* p, unsigned v) { return __hip_atomic_fetch_add(p, v, __ATOMIC_RELAXED, __HIP_MEMORY_SCOPE_AGENT); }
__device__ __forceinline__ unsigned xb_xcc_id() { return (unsigned)__builtin_amdgcn_s_getreg((3 << 11) | 20) & 0xFu; }
#define XB_SPIN(cond, bar) do { unsigned _sp = 0; while (cond) { __builtin_amdgcn_s_sleep(1); \
    if ((++_sp & 255u) == 0u) { if (xb_ld(&(bar)[XB_TMO])) break; if (_sp > XB_SPIN_CAP) { atomicAdd(&(bar)[XB_TMO], 1u); break; } } } } while (0)
struct XcdBarrier { unsigned* bar; unsigned x; volatile LAS unsigned* st; };
__device__ __forceinline__ XcdBarrier xcd_barrier_post(unsigned* bar, volatile LAS unsigned* st) {
    XcdBarrier b; b.bar = bar; b.x = xb_xcc_id(); b.st = st;
    if (threadIdx.x == 0) (void)xb_add(&bar[XB_XCNT(b.x)], 1u);
    return b;
}
__device__ __forceinline__ void xcd_barrier_complete(unsigned* bar, unsigned x, unsigned& nloc, unsigned& nx) {
    const unsigned G = gridDim.x * gridDim.y * gridDim.z;
    unsigned sum, cnt, mine, sp = 0u;
    for (;;) {
        sum = 0u; cnt = 0u; mine = 0u;
#pragma unroll
        for (unsigned j = 0; j < 16; ++j) { const unsigned c = xb_ld(&bar[XB_XCNT(j)]); sum += c; cnt += (c > 0u) ? 1u : 0u; mine = (j == x) ? c : mine; }
        if (sum == G) break;
        __builtin_amdgcn_s_sleep(1);
        if ((++sp & 255u) == 0u) { if (xb_ld(&bar[XB_TMO])) break; if (sp > XB_SPIN_CAP) { atomicAdd(&bar[XB_TMO], 1u); break; } }
    }
    nloc = mine > 0u ? mine : 1u; nx = cnt > 0u ? cnt : 1u;
}
__device__ __forceinline__ void xcd_barrier(const XcdBarrier& b) {
    asm volatile("s_waitcnt vmcnt(0)" ::: "memory");
    __syncthreads();
    if (threadIdx.x == 0) {
        unsigned* bar = b.bar;
        __builtin_amdgcn_s_waitcnt(0);
        unsigned nloc = b.st[0], nx = b.st[1];
        if (nloc == 0u) { xcd_barrier_complete(bar, b.x, nloc, nx); b.st[0] = nloc; b.st[1] = nx; }
        const unsigned old = xb_add(&bar[XB_XSUB(b.x)], 1u);
        const unsigned gen = old / nloc;
        if (old + 1u == (gen + 1u) * nloc) {
            __builtin_amdgcn_fence(__ATOMIC_RELEASE, "agent");
            asm volatile("s_waitcnt vmcnt(0)" ::: "memory");
            const unsigned og = xb_add(&bar[XB_TOP], 1u);
            const unsigned tg = og / nx;
            asm volatile("buffer_inv sc1" ::: "memory");
            if (og + 1u == (tg + 1u) * nx) xb_add(&bar[XB_TOPGEN], 1u);
            else XB_SPIN(xb_ld(&bar[XB_TOPGEN]) == tg, bar);
            __builtin_amdgcn_fence(__ATOMIC_ACQUIRE, "workgroup");
            asm volatile("s_waitcnt vmcnt(0)" ::: "memory");
        } else {
            asm volatile("buffer_inv sc1" ::: "memory");
            XB_SPIN(xb_ld(&bar[XB_TOPGEN]) == gen, bar);
            __builtin_amdgcn_fence(__ATOMIC_ACQUIRE, "workgroup");
            asm volatile("s_waitcnt vmcnt(0)" ::: "memory");
        }
    }
    __syncthreads();
}

__global__ void __launch_bounds__(512, 2) fwd(Args args) {
    extern __shared__ __attribute__((aligned(16))) unsigned char lds_raw[];
    LAS unsigned char* lds = (LAS unsigned char*)lds_raw;
    P p;
    p.x = (const float*)args.in[0]; p.c = (const float*)args.in[1]; p.ctx = (const float*)args.in[2]; p.c_ctx = (const float*)args.in[3];
    p.mod_w = (const float*)args.in[4]; p.mod_b = (const float*)args.in[5]; p.norm1_g = (const float*)args.in[6]; p.norm2_g = (const float*)args.in[7];
    p.f_w_in = (const float*)args.in[8]; p.f_w_out = (const float*)args.in[9]; p.h_w_in = (const float*)args.in[10]; p.h_lb = (const float*)args.in[11];
    p.h_norm_g = (const float*)args.in[12]; p.h_w_out = (const float*)args.in[13]; p.router_w = (const float*)args.in[14]; p.router_b = (const float*)args.in[15];
    p.e_w1 = (const float*)args.in[16]; p.e_b1 = (const float*)args.in[17]; p.e_w2 = (const float*)args.in[18]; p.e_b2 = (const float*)args.in[19]; p.final_g = (const float*)args.in[20];
    p.out = args.out; p.ws = args.ws;
    const int lo = args.ph_lo, hi = args.ph_hi;
    volatile LAS unsigned* misc = (volatile LAS unsigned*)(lds + LDS_MISC);
    if (threadIdx.x < 4) misc[threadIdx.x] = 0u;
    __syncthreads();
    XcdBarrier bar = xcd_barrier_post((unsigned*)(p.ws + WS_CTL), misc);
#define IN(k) (lo <= (k) && (k) < hi)
#define SEAM(k) do { if (IN(k) && IN((k) + 1)) xcd_barrier(bar); } while (0)
    if (IN(0)) ph_prologue(p, lds);
    SEAM(0);
    if (IN(1)) { ph_mod1_cdft(p, lds); ph_fprep1(p, lds); }
    SEAM(1);
    if (IN(2)) { ph_ctxdft(p, lds); ph_rdft(p, lds); ph_fprep2(p, lds); }
    if (IN(2) && IN(4)) xcd_barrier(bar);
    if (IN(4)) ph_gemm_f(p, lds);
    SEAM(4);
    if (IN(5)) { bg_catchup(p, 0); ph_mod2_route(p, 0, lds); }
    SEAM(5);
    if (IN(6)) ph_moe1(p, 0, lds);
    SEAM(6);
    if (IN(7)) ph_moe2(p, 0, lds);
    SEAM(7);
    if (IN(8)) ph_combine(p, 0);
    SEAM(8);
    if (IN(9)) ph_gemm_hi(p, lds);
    SEAM(9);
    if (IN(10)) { for (int u = blockIdx.x; u < 256; u += gridDim.x) scan_unit_mfma<false>(p, u, lds); }
    SEAM(10);
    if (IN(11)) { for (int u = blockIdx.x; u < 256; u += gridDim.x) scan_unit_mfma<true>(p, u, lds); }
    SEAM(11);
    if (IN(12)) ph_readout(p);
    SEAM(12);
    if (IN(13)) ph_gemm_ho(p, lds);
    SEAM(13);
    if (IN(14)) { bg_catchup(p, 1); ph_mod2_route(p, 1, lds); }
    SEAM(14);
    if (IN(15)) ph_moe1(p, 1, lds);
    SEAM(15);
    if (IN(16)) ph_moe2(p, 1, lds);
    SEAM(16);
    if (IN(17)) ph_combine(p, 1);
#undef SEAM
#undef IN
}

extern "C" void kernel_launch(void* const* d_in, const int* in_sizes, int n_in, void* d_out, int out_size, void* d_ws, size_t ws_size, hipStream_t stream) {
    static int grid = 0;
    if (grid == 0) {
        if (n_in != 21 || out_size != NLAT * D || ws_size < WS_END) { fprintf(stderr, "kernel_launch: unexpected shapes (n_in %d out %d ws %zu)\n", n_in, out_size, ws_size); grid = -1; return; }
        int dev = 0, cus = 0, per_cu = 0;
        (void)hipGetDevice(&dev); (void)hipDeviceGetAttribute(&cus, hipDeviceAttributeMultiprocessorCount, dev);
        if (hipFuncSetAttribute((const void*)fwd, hipFuncAttributeMaxDynamicSharedMemorySize, LDS_BYTES) != hipSuccess) { fprintf(stderr, "kernel_launch: hipFuncSetAttribute failed\n"); grid = -1; return; }
        if (hipOccupancyMaxActiveBlocksPerMultiprocessor(&per_cu, (const void*)fwd, 512, LDS_BYTES) != hipSuccess || per_cu < 1) { fprintf(stderr, "kernel_launch: occupancy query says %d blocks per CU\n", per_cu); grid = -1; return; }
        (void)hipGetLastError();
        if (cus < 256) { fprintf(stderr, "kernel_launch: built for a 256-CU device (one resident workgroup per CU)\n"); grid = -1; return; }
        grid = 256;
    }
    if (grid < 0) return;
    (void)hipMemsetAsync((char*)d_ws + WS_CTL, 0, CTL_BYTES, stream);
    Args a{};
    for (int i = 0; i < 21; ++i) a.in[i] = d_in[i];
    a.out = (float*)d_out; a.ws = (unsigned char*)d_ws;
#ifndef N_LAUNCHES
#define N_LAUNCHES 1
#endif
    if (N_LAUNCHES == 1) { a.ph_lo = 0; a.ph_hi = NPH; hipLaunchKernelGGL(fwd, dim3(grid), dim3(512), LDS_BYTES, stream, a); }
    else for (int ph = 0; ph < NPH; ++ph) { a.ph_lo = ph; a.ph_hi = ph + 1; hipLaunchKernelGGL(fwd, dim3(grid), dim3(512), LDS_BYTES, stream, a); }
}
```
